# Optimizing an MI355X kernel written in HIP

```python
import math
import jax, jax.numpy as jnp
from jax import lax
import numpy as np

D_MODEL = 1024
BATCH = 2
SEQ = 8192
DEPTH = 4

N_MIXERS = 2
N_LAYERS_A = (DEPTH + 1) // 2
N_LAYERS_B = DEPTH // 2

MEM_LEN = 256
MEM_HEADS = 4
MEM_HEAD_DIM = 64
MEM_WIDTH = MEM_HEADS * MEM_HEAD_DIM
TOK_WIDTH = D_MODEL - MEM_WIDTH

RNN_WIDTH = TOK_WIDTH
RNN_BLOCKS = 8
RNN_BLOCK_DIM = RNN_WIDTH // RNN_BLOCKS
CONV_WIDTH = 4
LRU_C = 8.0

DIFF_HEADS = 6
DIFF_QK_DIM = 64
DIFF_V_DIM = 2 * DIFF_QK_DIM
DIFF_QK_WIDTH = DIFF_HEADS * 2 * DIFF_QK_DIM
DIFF_V_WIDTH = DIFF_HEADS * DIFF_V_DIM
Q_BLOCK = 128

REL_BUCKETS = 32
REL_MAX_EXACT = 16
REL_MAX_DIST = 128

N_GROUPS = 4
EXPERTS_PER_GROUP = 4
N_EXPERTS = N_GROUPS * EXPERTS_PER_GROUP
TOP_K_INNER = 2
D_EXPERT = D_MODEL // 4

IN_A = 2 * RNN_WIDTH + MEM_WIDTH
IN_B = 2 * DIFF_QK_WIDTH + DIFF_V_WIDTH + MEM_WIDTH
EPS = 1e-6

kernel_name = "hybrid_rglru_diffattn_hiermoe"


def rmsnorm(x, g):
    x32 = x.astype(jnp.float32)
    y = x32 * lax.rsqrt(jnp.mean(x32 * x32, axis=-1, keepdims=True) + EPS) * g.astype(jnp.float32)
    return y.astype(x.dtype)


def t5_bucket(q_pos, k_pos):
    n = jnp.maximum(q_pos[:, None] - k_pos[None, :], 0)
    nf = jnp.maximum(n, 1).astype(jnp.float32)
    large = REL_MAX_EXACT + (jnp.log(nf / REL_MAX_EXACT) / math.log(REL_MAX_DIST / REL_MAX_EXACT)
                             * (REL_BUCKETS - REL_MAX_EXACT)).astype(jnp.int32)
    large = jnp.minimum(large, REL_BUCKETS - 1)
    return jnp.where(n < REL_MAX_EXACT, n, large)


def _lin_combine(c1, c2):
    a1, b1 = c1
    a2, b2 = c2
    return a1 * a2, a2 * b1 + b2


def rglru_mixer(u_x, u_gate, conv_w, conv_b, wa, ba, wx, bx, lam):
    B, S, C = u_x.shape
    xc = lax.conv_general_dilated(
        u_x, conv_w[:, None, :], window_strides=(1,), padding=[(CONV_WIDTH - 1, 0)],
        dimension_numbers=('NWC', 'WIO', 'NWC'), feature_group_count=C) + conv_b
    xb = xc.reshape(B, S, RNN_BLOCKS, RNN_BLOCK_DIM)
    r = jax.nn.sigmoid((jnp.einsum('bsgi,gij->bsgj', xb, wa).reshape(B, S, C) + ba).astype(jnp.float32))
    ig = jax.nn.sigmoid((jnp.einsum('bsgi,gij->bsgj', xb, wx).reshape(B, S, C) + bx).astype(jnp.float32))
    log_a = -LRU_C * r * jax.nn.softplus(-lam.astype(jnp.float32))
    a = jnp.exp(log_a)
    b = jnp.sqrt(-jnp.expm1(2.0 * log_a)) * (ig * xc.astype(jnp.float32))
    _, h = lax.associative_scan(_lin_combine, (a, b), axis=1)
    return (h * jax.nn.gelu(u_gate.astype(jnp.float32))).astype(u_x.dtype)


def diff_attention(q, k, v, lq1, lk1, lq2, lk2, subln_g, rel_bias, lambda_init):
    B, S, _ = q.shape
    qh = q.reshape(B, S, DIFF_HEADS, 2, DIFF_QK_DIM).transpose(3, 0, 2, 1, 4)
    kh = k.reshape(B, S, DIFF_HEADS, 2, DIFF_QK_DIM).transpose(3, 0, 2, 1, 4)
    vh = v.reshape(B, S, DIFF_HEADS, DIFF_V_DIM).transpose(0, 2, 1, 3)
    f32 = jnp.float32
    lam = (jnp.exp(jnp.sum(lq1.astype(f32) * lk1.astype(f32)))
           - jnp.exp(jnp.sum(lq2.astype(f32) * lk2.astype(f32))) + lambda_init)
    scale = DIFF_QK_DIM ** -0.5
    outs = []
    for blk in range(S // Q_BLOCK):
        start = blk * Q_BLOCK
        end = start + Q_BLOCK
        qb = qh[:, :, :, start:end]
        kb = kh[:, :, :, :end]
        s = jnp.einsum('nbhqd,nbhkd->nbhqk', qb, kb).astype(f32) * scale
        q_pos = jnp.arange(start, end)
        k_pos = jnp.arange(end)
        bias = rel_bias[t5_bucket(q_pos, k_pos)].astype(f32).transpose(2, 0, 1)
        s = jnp.where(k_pos[None, :] <= q_pos[:, None], s + bias, -jnp.inf)
        p = jax.nn.softmax(s, axis=-1)
        o = jnp.einsum('bhqk,bhkd->bhqd', p[0] - lam * p[1], vh[:, :, :end].astype(f32))
        outs.append(o)
    o = jnp.concatenate(outs, axis=2)
    o = rmsnorm(o, subln_g) * (1.0 - lambda_init)
    return o.transpose(0, 2, 1, 3).reshape(B, S, DIFF_V_WIDTH).astype(q.dtype)


def memory_attention(q_mem, mem_k, mem_v):
    B, S, _ = q_mem.shape
    qh = q_mem.reshape(B, S, MEM_HEADS, MEM_HEAD_DIM)
    s = jnp.einsum('bshd,bmhd->bhsm', qh, mem_k).astype(jnp.float32) * (MEM_HEAD_DIM ** -0.5)
    p = jax.nn.softmax(s, axis=-1)
    o = jnp.einsum('bhsm,bmhd->bshd', p, mem_v.astype(jnp.float32))
    return o.reshape(B, S, MEM_WIDTH).astype(q_mem.dtype)


def hier_moe(h, w_group, w_router, w1, w3, w2):
    B, S, D = h.shape
    t = h.reshape(B * S, D)
    g_logits = (t @ w_group).astype(jnp.float32)
    g_prob = jax.nn.softmax(g_logits, axis=-1)
    g_idx = jnp.argmax(g_logits, axis=-1)
    g_w = jnp.take_along_axis(g_prob, g_idx[:, None], axis=1)
    e_logits = (t @ w_router).astype(jnp.float32).reshape(-1, N_GROUPS, EXPERTS_PER_GROUP)
    e_in = jnp.take_along_axis(e_logits, g_idx[:, None, None], axis=1)[:, 0]
    top_v, top_i = lax.top_k(e_in, TOP_K_INNER)
    w = jax.nn.softmax(top_v, axis=-1) * g_w
    eid = g_idx[:, None] * EXPERTS_PER_GROUP + top_i
    gates = jnp.sum(jax.nn.one_hot(eid, N_EXPERTS, dtype=jnp.float32) * w[..., None], axis=1)
    a = jnp.einsum('td,edf->tef', t, w1)
    u = jnp.einsum('td,edf->tef', t, w3)
    hid = jax.nn.silu(a) * u * gates[:, :, None].astype(t.dtype)
    y = jnp.einsum('tef,efd->td', hid, w2)
    return y.reshape(B, S, D)


def setup_inputs(seed: int = 0) -> dict:
    key = jax.random.key(seed)
    ks = jax.random.split(key, 32)
    nrm = jax.random.normal
    f32 = jnp.float32
    u = jax.random.uniform(ks[12], (N_LAYERS_A, RNN_WIDTH), f32, minval=0.9, maxval=0.999)
    a0 = u ** (1.0 / LRU_C)
    lru_lambda = jnp.log(a0) - jnp.log1p(-a0)
    return {
        "x": nrm(ks[0], (BATCH, SEQ, D_MODEL), f32),
        "mem": nrm(ks[1], (BATCH, MEM_LEN, D_MODEL), f32),
        "norm_mix_g": 1.0 + 0.05 * nrm(ks[2], (DEPTH, D_MODEL), f32),
        "w_in_a": nrm(ks[3], (N_LAYERS_A, D_MODEL, IN_A), f32) * D_MODEL ** -0.5,
        "w_in_b": nrm(ks[4], (N_LAYERS_B, D_MODEL, IN_B), f32) * D_MODEL ** -0.5,
        "w_out": nrm(ks[5], (DEPTH, D_MODEL, D_MODEL), f32) * D_MODEL ** -0.5,
        "conv_w": nrm(ks[6], (N_LAYERS_A, CONV_WIDTH, RNN_WIDTH), f32) * CONV_WIDTH ** -0.5,
        "conv_b": 0.01 * nrm(ks[7], (N_LAYERS_A, RNN_WIDTH), f32),
        "gate_a_w": nrm(ks[8], (N_LAYERS_A, RNN_BLOCKS, RNN_BLOCK_DIM, RNN_BLOCK_DIM), f32) * RNN_BLOCK_DIM ** -0.5,
        "gate_a_b": 0.01 * nrm(ks[9], (N_LAYERS_A, RNN_WIDTH), f32),
        "gate_x_w": nrm(ks[10], (N_LAYERS_A, RNN_BLOCKS, RNN_BLOCK_DIM, RNN_BLOCK_DIM), f32) * RNN_BLOCK_DIM ** -0.5,
        "gate_x_b": 0.01 * nrm(ks[11], (N_LAYERS_A, RNN_WIDTH), f32),
        "lru_lambda": lru_lambda,
        "diff_lq1": 0.1 * nrm(ks[13], (N_LAYERS_B, DIFF_QK_DIM), f32),
        "diff_lk1": 0.1 * nrm(ks[14], (N_LAYERS_B, DIFF_QK_DIM), f32),
        "diff_lq2": 0.1 * nrm(ks[15], (N_LAYERS_B, DIFF_QK_DIM), f32),
        "diff_lk2": 0.1 * nrm(ks[16], (N_LAYERS_B, DIFF_QK_DIM), f32),
        "diff_subln_g": 1.0 + 0.05 * nrm(ks[17], (N_LAYERS_B, DIFF_V_DIM), f32),
        "rel_bias": 0.5 * nrm(ks[18], (REL_BUCKETS, DIFF_HEADS), f32),
        "mem_norm_g": 1.0 + 0.05 * nrm(ks[19], (D_MODEL,), f32),
        "w_mem_kv": nrm(ks[20], (DEPTH, D_MODEL, 2 * MEM_WIDTH), f32) * D_MODEL ** -0.5,
        "norm_ffn_g": 1.0 + 0.05 * nrm(ks[21], (DEPTH, D_MODEL), f32),
        "w_group": nrm(ks[22], (DEPTH, D_MODEL, N_GROUPS), f32) * D_MODEL ** -0.5,
        "w_router": nrm(ks[23], (DEPTH, D_MODEL, N_EXPERTS), f32) * D_MODEL ** -0.5,
        "w_exp1": nrm(ks[24], (DEPTH, N_EXPERTS, D_MODEL, D_EXPERT), f32) * D_MODEL ** -0.5,
        "w_exp3": nrm(ks[25], (DEPTH, N_EXPERTS, D_MODEL, D_EXPERT), f32) * D_MODEL ** -0.5,
        "w_exp2": nrm(ks[26], (DEPTH, N_EXPERTS, D_EXPERT, D_MODEL), f32) * D_EXPERT ** -0.5,
        "final_norm_g": 1.0 + 0.05 * nrm(ks[27], (D_MODEL,), f32),
    }


def reference(x, mem, norm_mix_g, w_in_a, w_in_b, w_out, conv_w, conv_b, gate_a_w, gate_a_b,
              gate_x_w, gate_x_b, lru_lambda, diff_lq1, diff_lk1, diff_lq2, diff_lk2, diff_subln_g,
              rel_bias, mem_norm_g, w_mem_kv, norm_ffn_g, w_group, w_router, w_exp1, w_exp3,
              w_exp2, final_norm_g):
    B = x.shape[0]
    mem_n = rmsnorm(mem, mem_norm_g)
    h = x
    for i in range(DEPTH):
        j = i // N_MIXERS
        hn = rmsnorm(h, norm_mix_g[i])
        kv = (mem_n @ w_mem_kv[i]).reshape(B, MEM_LEN, 2, MEM_HEADS, MEM_HEAD_DIM)
        if i % N_MIXERS == 0:
            proj = hn @ w_in_a[j]
            u_x, u_g, q_mem = jnp.split(proj, [RNN_WIDTH, 2 * RNN_WIDTH], axis=-1)
            tok = rglru_mixer(u_x, u_g, conv_w[j], conv_b[j], gate_a_w[j], gate_a_b[j],
                              gate_x_w[j], gate_x_b[j], lru_lambda[j])
        else:
            proj = hn @ w_in_b[j]
            q, k, v, q_mem = jnp.split(
                proj, [DIFF_QK_WIDTH, 2 * DIFF_QK_WIDTH, 2 * DIFF_QK_WIDTH + DIFF_V_WIDTH], axis=-1)
            lambda_init = 0.8 - 0.6 * math.exp(-0.3 * i)
            tok = diff_attention(q, k, v, diff_lq1[j], diff_lk1[j], diff_lq2[j], diff_lk2[j],
                                 diff_subln_g[j], rel_bias, lambda_init)
        mo = memory_attention(q_mem, kv[:, :, 0], kv[:, :, 1])
        h = h + jnp.concatenate([tok, mo], axis=-1) @ w_out[i]
        h = h + hier_moe(rmsnorm(h, norm_ffn_g[i]), w_group[i], w_router[i],
                         w_exp1[i], w_exp3[i], w_exp2[i])
    return rmsnorm(h, final_norm_g)
```

```cpp
#include <hip/hip_runtime.h>
#include <math.h>
#include <stdio.h>

namespace {
constexpr int D = 1024, NB = 2, S = 8192, T = NB * S, ML = 256, TW = 768, INB = 2560, DE = 256;
constexpr int PLD = 2560;
constexpr float EPS = 1e-6f;

__device__ const unsigned char BUCKET[128] = {
    0, 1, 2, 3, 4, 5, 6, 7, 8, 9, 10, 11, 12, 13, 14, 15, 16, 16, 16, 17, 17, 18, 18, 18, 19, 19, 19, 20, 20, 20, 20, 21, 21, 21, 21, 22, 22, 22, 22, 22,
    23, 23, 23, 23, 23, 23, 24, 24, 24, 24, 24, 24, 25, 25, 25, 25, 25, 25, 25, 26, 26, 26, 26, 26, 26, 26, 26, 27, 27, 27, 27, 27, 27, 27, 27, 27, 27,
    28, 28, 28, 28, 28, 28, 28, 28, 28, 28, 29, 29, 29, 29, 29, 29, 29, 29, 29, 29, 29, 29, 30, 30, 30, 30, 30, 30, 30, 30, 30, 30, 30, 30, 30, 30,
    31, 31, 31, 31, 31, 31, 31, 31, 31, 31, 31, 31, 31, 31, 31};

__device__ __forceinline__ float wave_sum(float v) {
#pragma unroll
    for (int o = 1; o < 64; o <<= 1) v += __shfl_xor(v, o);
    return v;
}
__device__ __forceinline__ float wave_max(float v) {
#pragma unroll
    for (int o = 1; o < 64; o <<= 1) v = fmaxf(v, __shfl_xor(v, o));
    return v;
}
__device__ __forceinline__ float sigmoidf_(float x) { return 1.0f / (1.0f + expf(-x)); }
__device__ __forceinline__ float gelu_tanh(float x) { return 0.5f * x * (1.0f + tanhf(0.7978845608028654f * (x + 0.044715f * x * x * x))); }

__global__ void __launch_bounds__(256) k_rmsnorm(const float* in, const float* g, float* out) {
    __shared__ float red[4];
    const int row = blockIdx.x, tid = threadIdx.x;
    const float4 v = ((const float4*)(in + (size_t)row * D))[tid];
    float ss = v.x * v.x + v.y * v.y + v.z * v.z + v.w * v.w;
    ss = wave_sum(ss);
    if ((tid & 63) == 0) red[tid >> 6] = ss;
    __syncthreads();
    const float tot = red[0] + red[1] + red[2] + red[3];
    const float r = rsqrtf(tot * (1.0f / D) + EPS);
    const float4 gg = ((const float4*)g)[tid];
    float4 o; o.x = v.x * r * gg.x; o.y = v.y * r * gg.y; o.z = v.z * r * gg.z; o.w = v.w * r * gg.w;
    ((float4*)(out + (size_t)row * D))[tid] = o;
}

template <bool ACC>
__global__ void __launch_bounds__(256) k_sgemm(const float* A, int lda, const float* Bm, int ldb, float* C, int ldc, int K) {
    __shared__ float As[16][68];
    __shared__ float Bs[16][68];
    const int bm = blockIdx.y * 64, bn = blockIdx.x * 64, tid = threadIdx.x, tx = tid & 15, ty = tid >> 4;
    float acc[4][4];
#pragma unroll
    for (int i = 0; i < 4; ++i)
#pragma unroll
        for (int j = 0; j < 4; ++j) acc[i][j] = 0.f;
    for (int k0 = 0; k0 < K; k0 += 16) {
#pragma unroll
        for (int i = 0; i < 4; ++i) {
            const int idx = tid + 256 * i;
            { const int m = idx >> 4, k = idx & 15; As[k][m] = A[(size_t)(bm + m) * lda + k0 + k]; }
            { const int k = idx >> 6, n = idx & 63; Bs[k][n] = Bm[(size_t)(k0 + k) * ldb + bn + n]; }
        }
        __syncthreads();
#pragma unroll
        for (int k = 0; k < 16; ++k) {
            float a[4], b[4];
#pragma unroll
            for (int i = 0; i < 4; ++i) { a[i] = As[k][ty * 4 + i]; b[i] = Bs[k][tx * 4 + i]; }
#pragma unroll
            for (int i = 0; i < 4; ++i)
#pragma unroll
                for (int j = 0; j < 4; ++j) acc[i][j] += a[i] * b[j];
        }
        __syncthreads();
    }
#pragma unroll
    for (int i = 0; i < 4; ++i)
#pragma unroll
        for (int j = 0; j < 4; ++j) {
            float* c = C + (size_t)(bm + ty * 4 + i) * ldc + bn + tx * 4 + j;
            if (ACC) *c += acc[i][j]; else *c = acc[i][j];
        }
}

__global__ void __launch_bounds__(256) k_conv(const float* proj, const float* cw, const float* cb, float* xc  ) {
    const int idx = blockIdx.x * 256 + threadIdx.x;
    if (idx >= T * TW) return;
    const int t = idx / TW, c = idx % TW, s = t % S;
    float acc = cb[c];
#pragma unroll
    for (int w = 0; w < 4; ++w) { const int ss = s + w - 3; if (ss >= 0) acc += cw[w * TW + c] * proj[(size_t)(t + w - 3) * PLD + c]; }
    xc[(size_t)t * D + c] = acc;
}
__global__ void __launch_bounds__(256) k_gates(const float* xc  , const float* wa, const float* ba, const float* wx, const float* bx, const float* lam,
                                              float* aout  , float* bout  ) {
    const int idx = blockIdx.x * 256 + threadIdx.x;
    if (idx >= T * TW) return;
    const int t = idx / TW, c = idx % TW, g = c / 96, jj = c % 96;
    const float* xr = xc + (size_t)t * D + g * 96;
    float ra = ba[c], ri = bx[c];
    for (int i = 0; i < 96; ++i) { const float x = xr[i]; ra += x * wa[(size_t)(g * 96 + i) * 96 + jj]; ri += x * wx[(size_t)(g * 96 + i) * 96 + jj]; }
    const float r = sigmoidf_(ra), ig = sigmoidf_(ri);
    const float nl = -lam[c];
    const float sp = fmaxf(nl, 0.f) + log1pf(expf(-fabsf(nl)));
    const float log_a = -8.0f * r * sp;
    const float a = expf(log_a);
    const float bb = sqrtf(-expm1f(2.0f * log_a)) * (ig * xc[(size_t)t * D + c]);
    aout[(size_t)t * TW + c] = a;
    bout[(size_t)t * PLD + c] = bb;
}
__global__ void __launch_bounds__(64) k_scan(const float* a, const float* bb  , const float* ug  , float* tok  ) {
    const int idx = blockIdx.x * 64 + threadIdx.x;
    if (idx >= NB * TW) return;
    const int b = idx / TW, c = idx % TW;
    float h = 0.f;
    for (int s0 = 0; s0 < S; s0 += 8) {
        float av[8], bv[8], gv[8];
#pragma unroll
        for (int k = 0; k < 8; ++k) { const size_t t = (size_t)b * S + s0 + k; av[k] = a[t * TW + c]; bv[k] = bb[t * PLD + c]; gv[k] = ug[t * PLD + c]; }
#pragma unroll
        for (int k = 0; k < 8; ++k) { const size_t t = (size_t)b * S + s0 + k; h = av[k] * h + bv[k]; tok[t * D + c] = h * gelu_tanh(gv[k]); }
    }
}

template <int DV>
__device__ __forceinline__ void attn_row(float qv  , const float* Kb, int ldk, const float* Vb, int ldv, int nkeys, int qpos, const float* bias, float (&o)[DV / 64]) {
    const int lane = threadIdx.x & 63;
    float m = -INFINITY, l = 0.f;
#pragma unroll
    for (int i = 0; i < DV / 64; ++i) o[i] = 0.f;
    for (int c0 = 0; c0 < nkeys; c0 += 64) {
        const int j = c0 + lane; const bool valid = j < nkeys;
        const float* kr = Kb + (size_t)(valid ? j : 0) * ldk;
        float acc = 0.f;
        for (int d = 0; d < 64; ++d) acc += __shfl(qv, d) * kr[d];
        float s = acc * 0.125f;
        if (bias) { int n = qpos - j; n = n < 0 ? 0 : (n > 127 ? 127 : n); s += bias[(int)BUCKET[n] * 6]; }
        if (!valid) s = -INFINITY;
        const float mn = fmaxf(m, wave_max(s));
        const float p = valid ? expf(s - mn) : 0.f;
        const float alpha = expf(m - mn);
        l = l * alpha + wave_sum(p);
#pragma unroll
        for (int i = 0; i < DV / 64; ++i) o[i] *= alpha;
        const int cnt = (nkeys - c0) < 64 ? (nkeys - c0) : 64;
        for (int jj = 0; jj < cnt; ++jj) {
            const float pj = __shfl(p, jj); const float* vr = Vb + (size_t)(c0 + jj) * ldv;
#pragma unroll
            for (int i = 0; i < DV / 64; ++i) o[i] += pj * vr[lane + 64 * i];
        }
        m = mn;
    }
    const float inv = 1.0f / l;
#pragma unroll
    for (int i = 0; i < DV / 64; ++i) o[i] *= inv;
}
__global__ void __launch_bounds__(256) k_diffattn(const float* proj, const float* rel_bias, const float* lq1, const float* lk1, const float* lq2, const float* lk2,
                                                 const float* subg, float lambda_init, float* cat) {
    const int lane = threadIdx.x & 63, r = blockIdx.x * 4 + (threadIdx.x >> 6);
    const int s = r % S, bh = r / S, h = bh % 6, b = bh / 6;
    const size_t t = (size_t)b * S + s;
    const float e1 = expf(wave_sum(lq1[lane] * lk1[lane])), e2 = expf(wave_sum(lq2[lane] * lk2[lane]));
    const float lam = e1 - e2 + lambda_init;
    float om0[2], om1[2];
    const float* Vb = proj + (size_t)b * S * PLD + 1536 + h * 128;
    attn_row<128>(proj[t * PLD + h * 128 + lane], proj + (size_t)b * S * PLD + 768 + h * 128, PLD, Vb, PLD, s + 1, s, rel_bias + h, om0);
    attn_row<128>(proj[t * PLD + h * 128 + 64 + lane], proj + (size_t)b * S * PLD + 768 + h * 128 + 64, PLD, Vb, PLD, s + 1, s, rel_bias + h, om1);
    float o[2]; o[0] = om0[0] - lam * om1[0]; o[1] = om0[1] - lam * om1[1];
    const float ss = wave_sum(o[0] * o[0] + o[1] * o[1]);
    const float rr = rsqrtf(ss * (1.0f / 128.0f) + EPS) * (1.0f - lambda_init);
    cat[t * D + h * 128 + lane] = o[0] * rr * subg[lane];
    cat[t * D + h * 128 + 64 + lane] = o[1] * rr * subg[64 + lane];
}
__global__ void __launch_bounds__(256) k_memattn(const float* proj, int qoff, const float* kv, float* cat) {
    const int lane = threadIdx.x & 63, r = blockIdx.x * 4 + (threadIdx.x >> 6);
    const int hd = r & 3; const size_t t = (size_t)(r >> 2); const int b = (int)(t / S);
    const float qv = proj[t * PLD + qoff + hd * 64 + lane];
    float o[1];
    attn_row<64>(qv, kv + (size_t)b * ML * 512 + hd * 64, 512, kv + (size_t)b * ML * 512 + 256 + hd * 64, 512, ML, 0, nullptr, o);
    cat[t * D + TW + hd * 64 + lane] = o[0];
}

__global__ void __launch_bounds__(256) k_route(const float* hn, const float* wg, const float* wr, int* eid, float* ew) {
    const int lane = threadIdx.x & 63; const size_t t = (size_t)blockIdx.x * 4 + (threadIdx.x >> 6);
    float acc[20];
#pragma unroll
    for (int o = 0; o < 20; ++o) acc[o] = 0.f;
    for (int d = lane; d < D; d += 64) {
        const float x = hn[t * D + d];
#pragma unroll
        for (int o = 0; o < 4; ++o) acc[o] += x * wg[d * 4 + o];
#pragma unroll
        for (int o = 0; o < 16; ++o) acc[4 + o] += x * wr[d * 16 + o];
    }
#pragma unroll
    for (int o = 0; o < 20; ++o) acc[o] = wave_sum(acc[o]);
    int gi = 0; float gm = acc[0];
#pragma unroll
    for (int o = 1; o < 4; ++o) if (acc[o] > gm) { gm = acc[o]; gi = o; }
    float gs = 0.f;
#pragma unroll
    for (int o = 0; o < 4; ++o) gs += expf(acc[o] - gm);
    const float gw = 1.0f / gs;
    float e[4];
#pragma unroll
    for (int k = 0; k < 4; ++k) { e[k] = acc[4 + k];
#pragma unroll
        for (int g = 1; g < 4; ++g) if (gi == g) e[k] = acc[4 + g * 4 + k]; }
    int i1 = 0; float v1 = e[0];
#pragma unroll
    for (int k = 1; k < 4; ++k) if (e[k] > v1) { v1 = e[k]; i1 = k; }
    int i2 = -1; float v2 = -INFINITY;
#pragma unroll
    for (int k = 0; k < 4; ++k) if (k != i1 && e[k] > v2) { v2 = e[k]; i2 = k; }
    const float ex = expf(v2 - v1);
    const float w1 = 1.0f / (1.0f + ex), w2 = ex / (1.0f + ex);
    if (lane == 0) { eid[t * 2] = gi * 4 + i1; eid[t * 2 + 1] = gi * 4 + i2; ew[t * 2] = w1 * gw; ew[t * 2 + 1] = w2 * gw; }
}
__global__ void __launch_bounds__(256) k_moe(const float* hn, const int* eid, const float* ew, const float* w1, const float* w3, const float* w2, float* h) {
    __shared__ float st[D];
    __shared__ float hid[DE];
    const int tid = threadIdx.x; const size_t t = blockIdx.x;
    for (int d = tid; d < D; d += 256) st[d] = hn[t * D + d];
    __syncthreads();
    float y[4] = {0.f, 0.f, 0.f, 0.f};
    for (int sidx = 0; sidx < 2; ++sidx) {
        const int e = eid[t * 2 + sidx]; const float wgt = ew[t * 2 + sidx];
        const float* p1 = w1 + (size_t)e * D * DE + tid; const float* p3 = w3 + (size_t)e * D * DE + tid;
        float a = 0.f, u = 0.f;
        for (int d = 0; d < D; ++d) { const float x = st[d]; a += x * p1[(size_t)d * DE]; u += x * p3[(size_t)d * DE]; }
        hid[tid] = (a / (1.0f + expf(-a))) * u * wgt;
        __syncthreads();
        const float* p2 = w2 + (size_t)e * DE * D + tid;
        for (int j = 0; j < DE; ++j) { const float hv = hid[j];
#pragma unroll
            for (int i = 0; i < 4; ++i) y[i] += hv * p2[(size_t)j * D + 256 * i]; }
        __syncthreads();
    }
#pragma unroll
    for (int i = 0; i < 4; ++i) h[t * D + tid + 256 * i] += y[i];
}
}

extern "C" void kernel_launch(void* const* d_in, const int* in_sizes, int n_in, void* d_out, int out_size, void* d_ws, size_t ws_size, hipStream_t stream) {
    const float* x = (const float*)d_in[0]; const float* mem = (const float*)d_in[1]; const float* norm_mix_g = (const float*)d_in[2];
    const float* w_in_a = (const float*)d_in[3]; const float* w_in_b = (const float*)d_in[4]; const float* w_out = (const float*)d_in[5];
    const float* conv_w = (const float*)d_in[6]; const float* conv_b = (const float*)d_in[7];
    const float* gate_a_w = (const float*)d_in[8]; const float* gate_a_b = (const float*)d_in[9]; const float* gate_x_w = (const float*)d_in[10]; const float* gate_x_b = (const float*)d_in[11];
    const float* lru_lambda = (const float*)d_in[12];
    const float* lq1 = (const float*)d_in[13]; const float* lk1 = (const float*)d_in[14]; const float* lq2 = (const float*)d_in[15]; const float* lk2 = (const float*)d_in[16];
    const float* subln_g = (const float*)d_in[17]; const float* rel_bias = (const float*)d_in[18]; const float* mem_norm_g = (const float*)d_in[19];
    const float* w_mem_kv = (const float*)d_in[20]; const float* norm_ffn_g = (const float*)d_in[21]; const float* w_group = (const float*)d_in[22]; const float* w_router = (const float*)d_in[23];
    const float* w_exp1 = (const float*)d_in[24]; const float* w_exp3 = (const float*)d_in[25]; const float* w_exp2 = (const float*)d_in[26]; const float* final_norm_g = (const float*)d_in[27];
    float* h = (float*)d_out;
    const size_t MiB = 1u << 20;
    if (ws_size < 300 * MiB || n_in != 28) { fprintf(stderr, "kernel_launch: unexpected ws_size %zu / n_in %d\n", ws_size, n_in); return; }
    char* ws = (char*)d_ws;
    float* hn = (float*)(ws);
    float* proj = (float*)(ws + 64 * MiB);
    float* cat = (float*)(ws + 224 * MiB);
    float* memn = (float*)(ws + 288 * MiB);
    float* kv = (float*)(ws + 290 * MiB);
    int* eid = (int*)(ws + 291 * MiB);
    float* ew = (float*)(ws + 292 * MiB);

    hipMemcpyAsync(h, x, (size_t)T * D * 4, hipMemcpyDeviceToDevice, stream);
    k_rmsnorm<<<NB * ML, 256, 0, stream>>>(mem, mem_norm_g, memn);
    for (int i = 0; i < 4; ++i) {
        const int j = i / 2;
        k_rmsnorm<<<T, 256, 0, stream>>>(h, norm_mix_g + i * D, hn);
        k_sgemm<false><<<dim3(512 / 64, 512 / 64), 256, 0, stream>>>(memn, D, w_mem_kv + (size_t)i * D * 512, 512, kv, 512, D);
        int qoff;
        if ((i & 1) == 0) {
            k_sgemm<false><<<dim3(1792 / 64, T / 64), 256, 0, stream>>>(hn, D, w_in_a + (size_t)j * D * 1792, 1792, proj, PLD, D);
            k_conv<<<T * TW / 256, 256, 0, stream>>>(proj, conv_w + (size_t)j * 4 * TW, conv_b + j * TW, cat);
            k_gates<<<T * TW / 256, 256, 0, stream>>>(cat, gate_a_w + (size_t)j * 8 * 96 * 96, gate_a_b + j * TW, gate_x_w + (size_t)j * 8 * 96 * 96, gate_x_b + j * TW, lru_lambda + j * TW,
                                                  hn, proj + 1792);
            k_scan<<<NB * TW / 64, 64, 0, stream>>>(hn, proj + 1792, proj + 768, cat);
            qoff = 1536;
        } else {
            k_sgemm<false><<<dim3(INB / 64, T / 64), 256, 0, stream>>>(hn, D, w_in_b + (size_t)j * D * INB, INB, proj, PLD, D);
            const float lambda_init = (float)(0.8 - 0.6 * exp(-0.3 * (double)i));
            k_diffattn<<<NB * 6 * S / 4, 256, 0, stream>>>(proj, rel_bias, lq1 + j * 64, lk1 + j * 64, lq2 + j * 64, lk2 + j * 64, subln_g + j * 128, lambda_init, cat);
            qoff = 2304;
        }
        k_memattn<<<T * 4 / 4, 256, 0, stream>>>(proj, qoff, kv, cat);
        k_sgemm<true><<<dim3(D / 64, T / 64), 256, 0, stream>>>(cat, D, w_out + (size_t)i * D * D, D, h, D, D);
        k_rmsnorm<<<T, 256, 0, stream>>>(h, norm_ffn_g + i * D, hn);
        k_route<<<T / 4, 256, 0, stream>>>(hn, w_group + (size_t)i * D * 4, w_router + (size_t)i * D * 16, eid, ew);
        k_moe<<<T, 256, 0, stream>>>(hn, eid, ew, w_exp1 + (size_t)i * 16 * D * DE, w_exp3 + (size_t)i * 16 * D * DE, w_exp2 + (size_t)i * 16 * DE * D, h);
    }
    k_rmsnorm<<<T, 256, 0, stream>>>(h, final_norm_g, h);
}
```

```cpp
#include <hip/hip_runtime.h>
#include <math.h>
#include <stdio.h>
#include <stdint.h>

#define LAS __attribute__((address_space(3)))
#define GAS __attribute__((address_space(1)))
typedef unsigned short bf16;
typedef short bf16x8 __attribute__((ext_vector_type(8)));
typedef float f32x4 __attribute__((ext_vector_type(4)));
typedef unsigned u32x4 __attribute__((ext_vector_type(4)));
typedef unsigned u32x2 __attribute__((ext_vector_type(2)));

constexpr int D = 1024, NB = 2, S = 8192, T = NB * S, ML = 256, TW = 768, INA = 1792, INB = 2560, DE = 256, NE = 16;
constexpr int PLD = 2560;
constexpr float EPS = 1e-6f;
constexpr int NWAVES = 8, NTHR = 512;

constexpr size_t MiB = 1u << 20;
constexpr size_t WS_CTL = 0, CTL_ZERO_BYTES = 1 * MiB;
constexpr size_t WS_W = 2 * MiB, W_LAYER = 31 * MiB, W_IN = 0, W_OUT = 5 * MiB, W_13 = 7 * MiB, W_2 = 23 * MiB;
constexpr size_t WS_WKV = 126 * MiB;
constexpr size_t WS_MEMN = 130 * MiB;
constexpr size_t WS_KVM = 131 * MiB;
constexpr size_t WS_HN = 133 * MiB;
constexpr size_t WS_CAT = 165 * MiB;
constexpr size_t WS_PROJ = 197 * MiB;
constexpr size_t WS_HID = 197 * MiB;
constexpr size_t WS_Y2 = 213 * MiB;
constexpr size_t WS_GW = 277 * MiB;
constexpr size_t WS_GP = 278 * MiB;
constexpr size_t WS_SUM = 279 * MiB;
constexpr size_t WS_EID = 281 * MiB;
constexpr size_t WS_EW = 282 * MiB;
constexpr size_t WS_LIST = 283 * MiB;
constexpr size_t WS_END = 284 * MiB;
constexpr int CW_AQ = 1024;
constexpr int CW_CNT = 2048;
constexpr int CW_BAR = 4096;

constexpr int RING_BYTES = 131072, LDSCTL_OFF = RING_BYTES, LDS_BYTES = 147456;

__device__ __forceinline__ unsigned cvt_pk_bf16(float lo, float hi) { unsigned r; asm volatile("v_cvt_pk_bf16_f32 %0, %1, %2" : "=v"(r) : "v"(lo), "v"(hi)); return r; }
__device__ __forceinline__ float bf2f(bf16 v) { return __uint_as_float(((unsigned)v) << 16); }
__device__ __forceinline__ float bflo(unsigned w) { return __uint_as_float(w << 16); }
__device__ __forceinline__ float bfhi(unsigned w) { return __uint_as_float(w & 0xffff0000u); }
__device__ __forceinline__ int lane_id() { int l = (int)__builtin_amdgcn_mbcnt_hi(~0u, __builtin_amdgcn_mbcnt_lo(~0u, 0u)); asm volatile("" : "+v"(l)); return l; }
__device__ __forceinline__ float wave_sum(float v) {
#pragma unroll
    for (int o = 1; o < 64; o <<= 1) v += __shfl_xor(v, o);
    return v;
}
__device__ __forceinline__ float wave_max(float v) {
#pragma unroll
    for (int o = 1; o < 64; o <<= 1) v = fmaxf(v, __shfl_xor(v, o));
    return v;
}
__device__ __forceinline__ float fast_sigmoid(float x) { return __builtin_amdgcn_rcpf(1.0f + __expf(-x)); }
__device__ __forceinline__ float gelu_tanh_fast(float x) {
    const float u = 0.7978845608028654f * (x + 0.044715f * x * x * x);
    return x * fast_sigmoid(2.0f * u);
}

__device__ const unsigned char BUCKET[128] = {
    0, 1, 2, 3, 4, 5, 6, 7, 8, 9, 10, 11, 12, 13, 14, 15, 16, 16, 16, 17, 17, 18, 18, 18, 19, 19, 19, 20, 20, 20, 20, 21, 21, 21, 21, 22, 22, 22, 22, 22,
    23, 23, 23, 23, 23, 23, 24, 24, 24, 24, 24, 24, 25, 25, 25, 25, 25, 25, 25, 26, 26, 26, 26, 26, 26, 26, 26, 27, 27, 27, 27, 27, 27, 27, 27, 27, 27,
    28, 28, 28, 28, 28, 28, 28, 28, 28, 28, 29, 29, 29, 29, 29, 29, 29, 29, 29, 29, 29, 29, 30, 30, 30, 30, 30, 30, 30, 30, 30, 30, 30, 30, 30, 30,
    31, 31, 31, 31, 31, 31, 31, 31, 31, 31, 31, 31, 31, 31, 31};

#define XB_TMO      128
#define XB_XCNT(j)  (256  + 64 * (j))
#define XB_XSUB(j)  (1280 + 64 * (j))
#define XB_XGEN(j)  (2304 + 64 * (j))
#define XB_TOP      3328
#define XB_TOPGEN   3392
#define XCD_BAR_WORDS 3456
#define XB_SPIN_CAP (1u << 22)

__device__ __forceinline__ unsigned xb_ld(unsigned* p)              { return __hip_atomic_load(p, __ATOMIC_RELAXED, __HIP_MEMORY_SCOPE_AGENT); }
__device__ __forceinline__ unsigned xb_add(unsigned* p, unsigned v) { return __hip_atomic_fetch_add(p, v, __ATOMIC_RELAXED, __HIP_MEMORY_SCOPE_AGENT); }
__device__ __forceinline__ unsigned xb_xcc_id() { return (unsigned)__builtin_amdgcn_s_getreg((3 << 11) | 20) & 0xFu; }
#define XB_SPIN(cond, bar) do { unsigned _sp = 0; while (cond) { __builtin_amdgcn_s_sleep(1); \
    if ((++_sp & 255u) == 0u) { if (xb_ld(&(bar)[XB_TMO])) break; if (_sp > XB_SPIN_CAP) { atomicAdd(&(bar)[XB_TMO], 1u); break; } } } } while (0)

struct XcdBarrier { unsigned* bar; unsigned x; volatile LAS unsigned* st; };

__device__ __forceinline__ XcdBarrier xcd_barrier_post(unsigned* bar, volatile LAS unsigned* st, bool leader) {
    XcdBarrier b; b.bar = bar; b.x = xb_xcc_id(); b.st = st;
    if (leader) (void)xb_add(&bar[XB_XCNT(b.x)], 1u);
    return b;
}
__device__ __forceinline__ void xcd_barrier_complete(unsigned* bar, unsigned x, unsigned& nloc, unsigned& nx) {
    const unsigned G = gridDim.x * gridDim.y * gridDim.z;
    unsigned sum, cnt, mine, sp = 0u;
    for (;;) {
        sum = 0u; cnt = 0u; mine = 0u;
#pragma unroll
        for (unsigned j = 0; j < 16; ++j) { const unsigned c = xb_ld(&bar[XB_XCNT(j)]); sum += c; cnt += (c > 0u) ? 1u : 0u; mine = (j == x) ? c : mine; }
        if (sum == G) break;
        __builtin_amdgcn_s_sleep(1);
        if ((++sp & 255u) == 0u) { if (xb_ld(&bar[XB_TMO])) break; if (sp > XB_SPIN_CAP) { atomicAdd(&bar[XB_TMO], 1u); break; } }
    }
    nloc = mine > 0u ? mine : 1u; nx = cnt > 0u ? cnt : 1u;
}
__device__ __forceinline__ void xcd_barrier(const XcdBarrier& b, bool leader) {
    asm volatile("s_waitcnt vmcnt(0)" ::: "memory");
    __syncthreads();
    if (leader) {
        unsigned* bar = b.bar;
        __builtin_amdgcn_s_waitcnt(0);
        unsigned nloc = b.st[0], nx = b.st[1];
        if (nloc == 0u) { xcd_barrier_complete(bar, b.x, nloc, nx); b.st[0] = nloc; b.st[1] = nx; }
        const unsigned old = xb_add(&bar[XB_XSUB(b.x)], 1u);
        const unsigned gen = old / nloc;
        if (old + 1u == (gen + 1u) * nloc) {
            __builtin_amdgcn_fence(__ATOMIC_RELEASE, "agent");
            asm volatile("s_waitcnt vmcnt(0)" ::: "memory");
            const unsigned og = xb_add(&bar[XB_TOP], 1u);
            const unsigned tg = og / nx;
            if (og + 1u == (tg + 1u) * nx) xb_add(&bar[XB_TOPGEN], 1u);
            else XB_SPIN(xb_ld(&bar[XB_TOPGEN]) == tg, bar);
            __builtin_amdgcn_fence(__ATOMIC_ACQUIRE, "agent");
            xb_add(&bar[XB_XGEN(b.x)], 1u);
            asm volatile("s_waitcnt vmcnt(0)" ::: "memory");
        } else {
            XB_SPIN(xb_ld(&bar[XB_XGEN(b.x)]) == gen, bar);
            __builtin_amdgcn_fence(__ATOMIC_ACQUIRE, "agent");
            asm volatile("s_waitcnt vmcnt(0)" ::: "memory");
        }
    }
    __syncthreads();
}

namespace pg8 {
constexpr int BM = 256, BK = 64, HALF = 128, HTB = HALF * BK * 2, STAGE_BYTES = 8 * HTB, NXCD = 8, WGM = 8;
__host__ __device__ __forceinline__ int lds_byte(int r, int c) { const int st = (r >> 4) * 2 + (c >> 5), rr = r & 15, cc = c & 31, ob = rr * 64 + cc * 2; return st * 1024 + (ob ^ (((ob >> 9) & 1) << 5)); }
__host__ __device__ __forceinline__ void stage_rc(int b, int& R, int& C) { const int st = b / 1024, sb = b % 1024, swz = sb ^ (((sb >> 9) & 1) << 5); R = (st >> 1) * 16 + swz / 64; C = (st & 1) * 32 + (swz % 64) / 2; }
__host__ __device__ __forceinline__ int perm32(int rho) { const int n = rho >> 4, i = rho & 15; return 8 * (i >> 2) + 4 * n + (i & 3); }

struct Unit { int pm, pn, e, cnt, par; };

struct DenseSched {
    static constexpr bool GATHER = false;
    const bf16* A; const bf16* Bt; int K, nM, nN, nwg, G, c;
    __device__ void init(const bf16* A_, const bf16* Bt_, int M, int N, int K_, int G_, int c_) { A = A_; Bt = Bt_; K = K_; nM = M / BM; nN = N / BM; nwg = nM * nN; G = G_; c = c_; }
    __device__ __forceinline__ bool next(int i, Unit& u) const {
        const long L = (long)i * G + c; if (L >= nwg) return false;
        int wgid = (int)L; { const int q = nwg / NXCD, r = nwg % NXCD, xcd = wgid % NXCD, off = wgid / NXCD; wgid = (xcd < r ? xcd * (q + 1) : r * (q + 1) + (xcd - r) * q) + off; }
        const int nig = WGM * nN, gid = wgid / nig, fm = gid * WGM, gsz = (nM - fm) < WGM ? (nM - fm) : WGM;
        u.pm = fm + ((wgid % nig) % gsz); u.pn = (wgid % nig) / gsz; u.e = 0; u.cnt = BM; u.par = 0; return true;
    }
    __device__ __forceinline__ const char* a_base(const Unit& u) const { return (const char*)A + (size_t)u.pm * BM * K * 2; }
    __device__ __forceinline__ const char* b_base(const Unit& u) const { return (const char*)Bt + (size_t)u.pn * BM * K * 2; }
};

template <class Epi, class Sched, bool ALIGN_EPI>
__device__ __forceinline__ void gemm_phase(LAS unsigned char* lds, const int wid, const int K, const Sched& S, const Epi& E) {
    const int lane = lane_id(), tid = wid * 64 + lane, wr = wid >> 2, wc = wid & 3, fr = lane & 15, fq = lane >> 4;
    const int nt = K / BK;
    int Rr[2], Cc[2]; unsigned voffB[2];
#pragma unroll
    for (int i = 0; i < 2; ++i) { int R, C; stage_rc(tid * 16 + i * 8192, R, C); Rr[i] = R; Cc[i] = C; const int Rb = Epi::PERM ? ((R & ~31) + perm32(R & 31)) : R;
        voffB[i] = (unsigned)(Rb * K + C) * 2u; }
    const size_t kstep = (size_t)(BK * 2);
    const size_t hstep = (size_t)HALF * K * 2;
    const unsigned ldsw = (unsigned)wid * 1024u;
    const int aoff = lds_byte(wr * 64 + fr, fq * 8), boff = lds_byte(wc * 32 + fr, fq * 8);
#define PG8_SA(b, h) (((b) * 2 + (h)) * HTB)
#define PG8_SB(b, h) ((4 + (b) * 2 + (h)) * HTB)
#define PG8_STAGE(bufoff, gbase, voff) do { _Pragma("unroll") for (int _i = 0; _i < 2; ++_i) \
        __builtin_amdgcn_global_load_lds((const unsigned*)((const char*)(gbase) + (voff)[_i]), (LAS unsigned*)(lds + (bufoff) + ldsw + _i * 8192), 16, 0, 0); } while (0)
#define PG8_LDA(dst, b, h) do { _Pragma("unroll") for (int m = 0; m < 4; ++m) _Pragma("unroll") for (int k = 0; k < 2; ++k) dst[m][k] = *(const LAS bf16x8*)(lds + PG8_SA(b, h) + aoff + m * 2048 + k * 1024); } while (0)
#define PG8_LDB(dst, b, h) do { _Pragma("unroll") for (int n = 0; n < 2; ++n) _Pragma("unroll") for (int k = 0; k < 2; ++k) dst[n][k] = *(const LAS bf16x8*)(lds + PG8_SB(b, h) + boff + n * 2048 + k * 1024); } while (0)
#define PG8_MMA(ai, bj, At, Bt) do { __builtin_amdgcn_s_setprio(1); _Pragma("unroll") for (int m = 0; m < 4; ++m) _Pragma("unroll") for (int n = 0; n < 2; ++n) _Pragma("unroll") for (int k = 0; k < 2; ++k) \
        acc[ai][bj][m][n] = __builtin_amdgcn_mfma_f32_16x16x32_bf16(Bt[n][k], At[m][k], acc[ai][bj][m][n], 0, 0, 0); __builtin_amdgcn_s_setprio(0); } while (0)
#define PG8_WAIT_V(n) asm volatile("s_waitcnt vmcnt(" #n ")" ::: "memory")
#define PG8_WAIT_L(n) asm volatile("s_waitcnt lgkmcnt(" #n ")" ::: "memory")
#define PG8_BAR __builtin_amdgcn_s_barrier()
#define PG8_SCHED __builtin_amdgcn_sched_barrier(0)
    Unit cur, nxt; int ui = 0;
    if (!S.next(0, cur)) return;
    cur.par = 0;
    f32x4 acc[2][2][4][2];
#pragma unroll
    for (int a = 0; a < 2; ++a)
#pragma unroll
        for (int b = 0; b < 2; ++b)
#pragma unroll
            for (int m = 0; m < 4; ++m)
#pragma unroll
                for (int n = 0; n < 2; ++n) acc[a][b][m][n] = (f32x4){0.f, 0.f, 0.f, 0.f};
    bf16x8 At[4][2], B0[2][2], B1[2][2];
    unsigned vAd[2][2];
#pragma unroll
    for (int h = 0; h < 2; ++h)
#pragma unroll
        for (int i = 0; i < 2; ++i) vAd[h][i] = (unsigned)((h * HALF + Rr[i]) * K + Cc[i]) * 2u;
    if constexpr (Sched::GATHER) { if (wid < 4) S.dma_slots(cur, 0, wid, tid); PG8_WAIT_V(0); __syncthreads(); }
#define PG8_STAGE_A(bufoff, gbase, par, h) do { if constexpr (Sched::GATHER) { unsigned _v[2]; _Pragma("unroll") for (int _i = 0; _i < 2; ++_i) _v[_i] = S.row_off(S.tabS[(par) * 256 + (h) * HALF + Rr[_i]]) + (unsigned)Cc[_i] * 2u; \
        PG8_WAIT_L(0); PG8_STAGE(bufoff, gbase, _v); } else { PG8_STAGE(bufoff, gbase, vAd[h]); } } while (0)
    const char* cA = S.a_base(cur); const char* cB = S.b_base(cur);
    PG8_STAGE(PG8_SB(0, 0), cB, voffB); PG8_STAGE(PG8_SB(0, 1), cB + hstep, voffB); PG8_STAGE_A(PG8_SA(0, 0), cA, 0, 0); PG8_STAGE_A(PG8_SA(0, 1), cA, 0, 1);
    if (wr == 1) PG8_BAR;
    PG8_WAIT_V(2); PG8_BAR;
    PG8_STAGE(PG8_SB(1, 0), cB + kstep, voffB); PG8_STAGE_A(PG8_SA(1, 0), cA + kstep, 0, 0); PG8_STAGE(PG8_SB(1, 1), cB + hstep + kstep, voffB);
    PG8_WAIT_V(6); PG8_BAR;
    for (;;) {
        const bool has_next = S.next(ui + 1, nxt);
        const int pc = ui & 1, pn_ = pc ^ 1;
        nxt.par = pn_;
        const char* nA = has_next ? S.a_base(nxt) : cA; const char* nB = has_next ? S.b_base(nxt) : cB;
#pragma nounroll
        for (int t = 0; t < nt; t += 2) {
            const bool last = (t == nt - 2);
            const char* a1 = cA + (size_t)(t + 1) * kstep;
            const char* a2 = last ? nA : cA + (size_t)(t + 2) * kstep; const char* b2 = last ? nB : cB + (size_t)(t + 2) * kstep;
            const char* a3 = a2 + kstep; const char* b3 = b2 + kstep;
            const int p2 = (last && has_next) ? pn_ : pc;
            PG8_LDB(B0, 0, 0); PG8_LDB(B1, 0, 1); PG8_SCHED; PG8_LDA(At, 0, 0); PG8_STAGE_A(PG8_SA(1, 1), a1, pc, 1);
            PG8_WAIT_V(8); PG8_WAIT_L(0); PG8_BAR; PG8_MMA(0, 0, At, B0); PG8_MMA(0, 1, At, B1); PG8_BAR; PG8_SCHED;
            PG8_LDA(At, 0, 1); PG8_STAGE(PG8_SB(0, 0), b2, voffB); PG8_STAGE(PG8_SB(0, 1), b2 + hstep, voffB); PG8_STAGE_A(PG8_SA(0, 0), a2, p2, 0);
            PG8_WAIT_V(8); PG8_WAIT_L(0); PG8_BAR; PG8_MMA(1, 0, At, B0); PG8_MMA(1, 1, At, B1); PG8_BAR; PG8_SCHED;
            if constexpr (Sched::GATHER) { if (t == 0 && has_next && wid < 4) S.dma_slots(nxt, pn_, wid, tid); }
            PG8_LDB(B0, 1, 0); PG8_LDB(B1, 1, 1); PG8_SCHED; PG8_LDA(At, 1, 0); PG8_STAGE_A(PG8_SA(0, 1), a2, p2, 1);
            PG8_WAIT_V(8); PG8_WAIT_L(0); PG8_BAR; PG8_MMA(0, 0, At, B0); PG8_MMA(0, 1, At, B1); PG8_BAR; PG8_SCHED;
            PG8_LDA(At, 1, 1); PG8_STAGE(PG8_SB(1, 0), b3, voffB); PG8_STAGE(PG8_SB(1, 1), b3 + hstep, voffB); PG8_STAGE_A(PG8_SA(1, 0), a3, p2, 0);
            PG8_WAIT_V(8); PG8_WAIT_L(0); PG8_BAR; PG8_MMA(1, 0, At, B0); PG8_MMA(1, 1, At, B1); PG8_BAR; PG8_SCHED;
        }
        if constexpr (ALIGN_EPI) { if (wr == 0) PG8_BAR; }
        E(acc, cur, wr, wc, fr, fq);
        if (!has_next) break;
#pragma unroll
        for (int a = 0; a < 2; ++a)
#pragma unroll
            for (int b = 0; b < 2; ++b)
#pragma unroll
                for (int m = 0; m < 4; ++m)
#pragma unroll
                    for (int n = 0; n < 2; ++n) acc[a][b][m][n] = (f32x4){0.f, 0.f, 0.f, 0.f};
        cur = nxt; cA = nA; cB = nB; ++ui;
        if constexpr (ALIGN_EPI) { if (wr == 1) PG8_BAR; }
    }
    PG8_WAIT_V(0);
    if constexpr (!ALIGN_EPI) { if (wr == 0) PG8_BAR; }
    PG8_BAR;
#undef PG8_SA
#undef PG8_SB
#undef PG8_STAGE
#undef PG8_STAGE_A
#undef PG8_LDA
#undef PG8_LDB
#undef PG8_MMA
#undef PG8_WAIT_V
#undef PG8_WAIT_L
#undef PG8_BAR
#undef PG8_SCHED
}

struct EpiStoreBf16 {
    static constexpr bool PERM = true;
    bf16* O; int ldc;
    __device__ __forceinline__ void operator()(const f32x4 (&acc)[2][2][4][2], const Unit& u, int wr, int wc, int fr, int fq) const {
        const int row0 = u.pm * BM + wr * 64 + fr, col0 = u.pn * BM + wc * 32 + 8 * fq;
#pragma unroll
        for (int ai = 0; ai < 2; ++ai)
#pragma unroll
            for (int m = 0; m < 4; ++m) { bf16* rowp = O + (size_t)(row0 + ai * HALF + m * 16) * ldc + col0;
#pragma unroll
                for (int bj = 0; bj < 2; ++bj) { const f32x4 v0 = acc[ai][bj][m][0], v1 = acc[ai][bj][m][1];
                    u32x4 w; w.x = cvt_pk_bf16(v0[0], v0[1]); w.y = cvt_pk_bf16(v0[2], v0[3]); w.z = cvt_pk_bf16(v1[0], v1[1]); w.w = cvt_pk_bf16(v1[2], v1[3]);
                    *(u32x4*)(rowp + bj * HALF) = w; } }
    }
};
struct EpiResF32 {
    static constexpr bool PERM = false;
    const float* base; float* out; int ldc;
    __device__ __forceinline__ void operator()(const f32x4 (&acc)[2][2][4][2], const Unit& u, int wr, int wc, int fr, int fq) const {
        const int col0 = u.pn * BM + wc * 32 + 4 * fq;
#pragma unroll
        for (int ai = 0; ai < 2; ++ai)
#pragma unroll
            for (int m = 0; m < 4; ++m) { const size_t off = (size_t)(u.pm * BM + ai * HALF + wr * 64 + m * 16 + fr) * ldc + col0;
#pragma unroll
                for (int bj = 0; bj < 2; ++bj)
#pragma unroll
                    for (int n = 0; n < 2; ++n) { const f32x4 bs = *(const f32x4*)(base + off + bj * HALF + n * 16); *(f32x4*)(out + off + bj * HALF + n * 16) = bs + acc[ai][bj][m][n]; }
                if (m & 1) asm volatile("" ::: "memory"); }
    }
};
struct MoeSched {
    static constexpr bool GATHER = true;
    const bf16* A; const bf16* Bt; int K; size_t bt_estride; int npn, shift; const int* list; const LAS int* tab  ;
    LAS int* tabS  ; int G, c;
    __device__ __forceinline__ bool next(int i, Unit& u) const {
        const int L = i * G + c, nu = __builtin_amdgcn_readfirstlane(tab[32]) * npn; if (L >= nu) return false;
        const int ti = L / npn; u.pn = L % npn; int e = 0;
#pragma unroll
        for (int k = 1; k < 16; ++k) if (ti >= __builtin_amdgcn_readfirstlane(tab[16 + k])) e = k;
        u.e = e; u.pm = ti - __builtin_amdgcn_readfirstlane(tab[16 + e]); const int rem = __builtin_amdgcn_readfirstlane(tab[e]) - BM * u.pm; u.cnt = rem < BM ? rem : BM; u.par = 0; return true;
    }
    __device__ __forceinline__ const char* a_base(const Unit&) const { return (const char*)A; }
    __device__ __forceinline__ const char* b_base(const Unit& u) const { return (const char*)Bt + (size_t)u.e * bt_estride + (size_t)u.pn * BM * K * 2; }
    __device__ __forceinline__ void dma_slots(const Unit& u, int par, int wid, int tid) const {
        const int rr = tid < u.cnt ? tid : u.cnt - 1;
        __builtin_amdgcn_global_load_lds((const unsigned*)(list + (size_t)u.e * T + BM * u.pm + rr), (LAS unsigned*)(tabS + par * 256 + wid * 64), 4, 0, 0); }
    __device__ __forceinline__ unsigned row_off(int slot) const { return (unsigned)(slot >> shift) * (unsigned)(K * 2); }
};
struct EpiMoe1 {
    static constexpr bool PERM = true;
    bf16* hid; const LAS int* tabS; const float* ew;
    __device__ __forceinline__ void operator()(const f32x4 (&acc)[2][2][4][2], const Unit& u, int wr, int wc, int fr, int fq) const {
#pragma unroll
        for (int ai = 0; ai < 2; ++ai)
#pragma unroll
            for (int m = 0; m < 4; ++m) { const int r = ai * HALF + wr * 64 + m * 16 + fr;
                const int slot = tabS[u.par * 256 + r];
                if (r < u.cnt) { const float w = ew[slot];
                    float hv[8];
#pragma unroll
                    for (int n = 0; n < 2; ++n)
#pragma unroll
                        for (int k = 0; k < 4; ++k) { const float a = acc[ai][0][m][n][k], uu = acc[ai][1][m][n][k]; hv[4 * n + k] = a * __builtin_amdgcn_rcpf(1.0f + __expf(-a)) * uu * w; }
                    u32x4 o; o.x = cvt_pk_bf16(hv[0], hv[1]); o.y = cvt_pk_bf16(hv[2], hv[3]); o.z = cvt_pk_bf16(hv[4], hv[5]); o.w = cvt_pk_bf16(hv[6], hv[7]);
                    *(u32x4*)(hid + (size_t)slot * DE + u.pn * HALF + wc * 32 + 8 * fq) = o; } }
    }
};
struct EpiMoe2 {
    static constexpr bool PERM = true;
    bf16* y2; const LAS int* tabS;
    __device__ __forceinline__ void operator()(const f32x4 (&acc)[2][2][4][2], const Unit& u, int wr, int wc, int fr, int fq) const {
#pragma unroll
        for (int ai = 0; ai < 2; ++ai)
#pragma unroll
            for (int m = 0; m < 4; ++m) { const int r = ai * HALF + wr * 64 + m * 16 + fr;
                const int slot = tabS[u.par * 256 + r];
                if (r < u.cnt) {
                    bf16* rowp = y2 + (size_t)slot * D + u.pn * BM + wc * 32 + 8 * fq;
#pragma unroll
                    for (int bj = 0; bj < 2; ++bj) { const f32x4 v0 = acc[ai][bj][m][0], v1 = acc[ai][bj][m][1];
                        u32x4 o; o.x = cvt_pk_bf16(v0[0], v0[1]); o.y = cvt_pk_bf16(v0[2], v0[3]); o.z = cvt_pk_bf16(v1[0], v1[1]); o.w = cvt_pk_bf16(v1[2], v1[3]);
                        *(u32x4*)(rowp + bj * HALF) = o; } } }
    }
};
}

struct Args { const float* in[28]; float* out; unsigned char* ws; int ph_mask, seam_mask, l_lo, l_hi, li, pad; };
enum { I_X = 0, I_MEM, I_NMG, I_WINA, I_WINB, I_WOUT, I_CW, I_CB, I_GAW, I_GAB, I_GXW, I_GXB, I_LAM, I_LQ1, I_LK1, I_LQ2, I_LK2, I_SUBG, I_RELB, I_MNG, I_WKV, I_NFG, I_WG, I_WR, I_W1, I_W3, I_W2, I_FNG };
enum { K_PRO = 0, K_KVM, K_N1, K_G1, K_M1, K_M2, K_G2, K_N2, K_E1, K_E2, K_FIN, K_NUM };

__device__ __forceinline__ void transpose_item(const float* W, int ldw, int k0, int nsrc0, bf16* WT, int ldt, int drow0, float scale, LAS float* scr, int lane) {
#pragma unroll 8
    for (int i = 0; i < 32; ++i) { const int kk = 2 * i + (lane >> 5); scr[kk * 33 + (lane & 31)] = W[(size_t)(k0 + kk) * ldw + nsrc0 + (lane & 31)] * scale; }
    asm volatile("s_waitcnt lgkmcnt(0)" ::: "memory");
    const int c = lane & 7;
#pragma unroll
    for (int j = 0; j < 4; ++j) { const int n = (lane >> 3) + 8 * j; const LAS float* s = scr + (8 * c) * 33 + n;
        u32x4 o; o.x = cvt_pk_bf16(s[0 * 33], s[1 * 33]); o.y = cvt_pk_bf16(s[2 * 33], s[3 * 33]); o.z = cvt_pk_bf16(s[4 * 33], s[5 * 33]); o.w = cvt_pk_bf16(s[6 * 33], s[7 * 33]);
        *(u32x4*)(WT + (size_t)(drow0 + n) * ldt + k0 + 8 * c) = o; }
    asm volatile("s_waitcnt lgkmcnt(0)" ::: "memory");
}
__device__ __forceinline__ void norm_row(const float* xrow, const bf16* y0, const bf16* y1, float* hrow_out, const float* g, bf16* orow, float* frow, int lane) {
    asm volatile("" : "+v"(lane));
    f32x4 v[4]; float ss = 0.f;
#pragma unroll
    for (int j = 0; j < 4; ++j) {
        v[j] = ((const f32x4*)xrow)[64 * j + lane];
        if (y0) { const u32x2 a = ((const u32x2*)y0)[64 * j + lane], b = ((const u32x2*)y1)[64 * j + lane];
            v[j][0] += bflo(a.x) + bflo(b.x); v[j][1] += bfhi(a.x) + bfhi(b.x); v[j][2] += bflo(a.y) + bflo(b.y); v[j][3] += bfhi(a.y) + bfhi(b.y); }
        ss += (v[j][0] * v[j][0] + v[j][1] * v[j][1]) + (v[j][2] * v[j][2] + v[j][3] * v[j][3]);
    }
    if (hrow_out) {
#pragma unroll
        for (int j = 0; j < 4; ++j) ((f32x4*)hrow_out)[64 * j + lane] = v[j];
    }
    const float r = rsqrtf(wave_sum(ss) * (1.0f / D) + EPS);
#pragma unroll
    for (int j = 0; j < 4; ++j) {
        const f32x4 gg = ((const f32x4*)g)[64 * j + lane];
        const f32x4 o = v[j] * r * gg;
        if (orow) { u32x2 w; w.x = cvt_pk_bf16(o[0], o[1]); w.y = cvt_pk_bf16(o[2], o[3]); ((u32x2*)orow)[64 * j + lane] = w; }
        if (frow) ((f32x4*)frow)[64 * j + lane] = o;
    }
}

constexpr int RG_L = 128, RG_NCH = S / RG_L;
constexpr int RG_XF = 0, RG_AF = 51200, RG_XB = 102400;
template <int PASS>
__device__ __forceinline__ void rglru_unit(LAS unsigned char* lds, const int wid, int b, int c, int g, const bf16* proj, const float* cw, const float* cb, const bf16* gw  ,
                                           const float* gp  , float* sumA, float* sumB, bf16* cat) {
    const int lane = lane_id(), tid = wid * 64 + lane;
    LAS float* XF = (LAS float*)(lds + RG_XF); LAS float* AF = (LAS float*)(lds + RG_AF); LAS bf16* XB = (LAS bf16*)(lds + RG_XB);
    float hc = 0.f;
    if (PASS == 2 && tid < 96) {
        const float* pa = sumA + (size_t)b * RG_NCH * TW + g * 96 + tid; const float* pb = sumB + (size_t)b * RG_NCH * TW + g * 96 + tid;
        int cc = 0;
        for (; cc + 8 <= c; cc += 8) { float av[8], bv[8];
#pragma unroll
            for (int k = 0; k < 8; ++k) { av[k] = pa[(size_t)(cc + k) * TW]; bv[k] = pb[(size_t)(cc + k) * TW]; }
#pragma unroll
            for (int k = 0; k < 8; ++k) hc = av[k] * hc + bv[k]; }
        for (; cc < c; ++cc) hc = pa[(size_t)cc * TW] * hc + pb[(size_t)cc * TW];
    }
    const int tk = tid >> 2, cq = tid & 3, ch0 = cq * 24;
    const int s = c * RG_L + tk; const size_t t = (size_t)b * S + s;
    {
        float acc[24];
#pragma unroll
        for (int k = 0; k < 24; k += 4) { const f32x4 v = *(const f32x4*)(cb + g * 96 + ch0 + k); acc[k] = v[0]; acc[k + 1] = v[1]; acc[k + 2] = v[2]; acc[k + 3] = v[3]; }
#pragma unroll
        for (int w = 0; w < 4; ++w) {
            if (s + w - 3 >= 0) {
                const bf16* xr = proj + (t + w - 3) * PLD + g * 96 + ch0;
#pragma unroll
                for (int q = 0; q < 3; ++q) {
                    const u32x4 xv = *(const u32x4*)(xr + 8 * q);
                    const f32x4 w0 = *(const f32x4*)(cw + w * TW + g * 96 + ch0 + 8 * q), w1 = *(const f32x4*)(cw + w * TW + g * 96 + ch0 + 8 * q + 4);
                    acc[8 * q + 0] += w0[0] * bflo(xv.x); acc[8 * q + 1] += w0[1] * bfhi(xv.x); acc[8 * q + 2] += w0[2] * bflo(xv.y); acc[8 * q + 3] += w0[3] * bfhi(xv.y);
                    acc[8 * q + 4] += w1[0] * bflo(xv.z); acc[8 * q + 5] += w1[1] * bfhi(xv.z); acc[8 * q + 6] += w1[2] * bflo(xv.w); acc[8 * q + 7] += w1[3] * bfhi(xv.w);
                }
            }
        }
#pragma unroll
        for (int k = 0; k < 24; k += 4) *(LAS f32x4*)(XF + tk * 100 + ch0 + k) = (f32x4){acc[k], acc[k + 1], acc[k + 2], acc[k + 3]};
#pragma unroll
        for (int q = 0; q < 3; ++q) { u32x4 w; w.x = cvt_pk_bf16(acc[8 * q], acc[8 * q + 1]); w.y = cvt_pk_bf16(acc[8 * q + 2], acc[8 * q + 3]); w.z = cvt_pk_bf16(acc[8 * q + 4], acc[8 * q + 5]); w.w = cvt_pk_bf16(acc[8 * q + 6], acc[8 * q + 7]);
            *(LAS u32x4*)(XB + tk * 104 + ch0 + 8 * q) = w; }
    }
    __syncthreads();
    {
        const int fr = lane & 15, fq = lane >> 4;
        bf16x8 af[3];
#pragma unroll
        for (int ks = 0; ks < 3; ++ks) af[ks] = *(const LAS bf16x8*)(XB + (16 * wid + fr) * 104 + ks * 32 + 8 * fq);
#pragma unroll
        for (int nt = 0; nt < 6; ++nt) {
            f32x4 dr = (f32x4){0.f, 0.f, 0.f, 0.f}, di = dr;
#pragma unroll
            for (int ks = 0; ks < 3; ++ks) {
                const bf16x8 br = *(const bf16x8*)(gw + ((size_t)(0 * 8 + g) * 96 + nt * 16 + fr) * 96 + ks * 32 + 8 * fq);
                const bf16x8 bi = *(const bf16x8*)(gw + ((size_t)(1 * 8 + g) * 96 + nt * 16 + fr) * 96 + ks * 32 + 8 * fq);
                dr = __builtin_amdgcn_mfma_f32_16x16x32_bf16(af[ks], br, dr, 0, 0, 0);
                di = __builtin_amdgcn_mfma_f32_16x16x32_bf16(af[ks], bi, di, 0, 0, 0);
            }
            const int ch = nt * 16 + fr, chg = g * 96 + ch;
            const float ba = gp[chg], bx = gp[TW + chg], c8 = gp[2 * TW + chg];
#pragma unroll
            for (int i = 0; i < 4; ++i) {
                const int tkk = 16 * wid + 4 * fq + i;
                const float r = fast_sigmoid(dr[i] + ba), ig = fast_sigmoid(di[i] + bx);
                const float la = c8 * r;
                const float a = __expf(la);
                const float x2 = 2.0f * la;
                float p = 1.0f + x2 * (1.0f / 7.0f); p = 1.0f + x2 * (1.0f / 6.0f) * p; p = 1.0f + x2 * (1.0f / 5.0f) * p; p = 1.0f + x2 * 0.25f * p; p = 1.0f + x2 * (1.0f / 3.0f) * p; p = 1.0f + x2 * 0.5f * p;
                float om = -x2 * p;
                if (x2 < -0.25f) om = 1.0f - a * a;
                const float bc = sqrtf(om);
                const float xv = XF[tkk * 100 + ch];
                AF[tkk * 100 + ch] = a;
                XF[tkk * 100 + ch] = bc * (ig * xv);
            }
        }
    }
    __syncthreads();
    if (tid < 96) {
        float h = hc, ap = 1.f;
        for (int k0 = 0; k0 < RG_L; k0 += 16) {
            float av[16], bv[16];
#pragma unroll
            for (int k = 0; k < 16; ++k) { av[k] = AF[(k0 + k) * 100 + tid]; bv[k] = XF[(k0 + k) * 100 + tid]; }
#pragma unroll
            for (int k = 0; k < 16; ++k) { h = av[k] * h + bv[k]; if (PASS == 1) ap *= av[k]; else XF[(k0 + k) * 100 + tid] = h; }
        }
        if (PASS == 1) { sumA[((size_t)b * RG_NCH + c) * TW + g * 96 + tid] = ap; sumB[((size_t)b * RG_NCH + c) * TW + g * 96 + tid] = h; }
    }
    if (PASS == 2) {
        __syncthreads();
        const bf16* ugr = proj + t * PLD + TW + g * 96 + ch0;
        bf16* orow = cat + t * D + g * 96 + ch0;
#pragma unroll
        for (int q = 0; q < 3; ++q) {
            const u32x4 uv = *(const u32x4*)(ugr + 8 * q);
            const f32x4 h0 = *(const LAS f32x4*)(XF + tk * 100 + ch0 + 8 * q), h1 = *(const LAS f32x4*)(XF + tk * 100 + ch0 + 8 * q + 4);
            u32x4 w;
            w.x = cvt_pk_bf16(h0[0] * gelu_tanh_fast(bflo(uv.x)), h0[1] * gelu_tanh_fast(bfhi(uv.x)));
            w.y = cvt_pk_bf16(h0[2] * gelu_tanh_fast(bflo(uv.y)), h0[3] * gelu_tanh_fast(bfhi(uv.y)));
            w.z = cvt_pk_bf16(h1[0] * gelu_tanh_fast(bflo(uv.z)), h1[1] * gelu_tanh_fast(bfhi(uv.z)));
            w.w = cvt_pk_bf16(h1[2] * gelu_tanh_fast(bflo(uv.w)), h1[3] * gelu_tanh_fast(bfhi(uv.w)));
            *(u32x4*)(orow + 8 * q) = w;
        }
    }
    __syncthreads();
}

namespace att {
typedef float f32x16 __attribute__((ext_vector_type(16)));
typedef short s16x4 __attribute__((ext_vector_type(4)));
constexpr int SLOT = 32768, NSLOT = 3, L_K = 0, L_V = 16384;
constexpr int L_WSF = NSLOT * SLOT, L_TB = L_WSF + 8 * 256, L_END = L_TB + 512;
constexpr int L_X = 0, L_OST = 65536;
constexpr float THR = 8.0f, LOG2E = 1.4426950408889634f;
static_assert(L_END <= RING_BYTES && L_OST + 32768 <= L_WSF, "attention LDS map");
__device__ __forceinline__ int crow(int r, int hi) { return (r & 3) + 8 * (r >> 2) + 4 * hi; }
#define ATT_WAIT_BAR(N) asm volatile("s_waitcnt vmcnt(" #N ") lgkmcnt(0)\n\ts_barrier" ::: "memory")
#define ATT_MFMA(a, b, c) __builtin_amdgcn_mfma_f32_32x32x16_bf16(a, b, c, 0, 0, 0)

template <int MODE>
__device__ __forceinline__ void attn_unit(LAS unsigned char* lds, const int wid, const int b, const int hh, const int qb,
                                          const bf16* proj, const bf16* kvm, const int layer, const int qoff, const float* rel_bias, const float* subg, const float lam, const float lambda_init, bf16* cat) {
    const int lane = lane_id(), r32 = lane & 31, hi = lane >> 5, mp = wid >> 2, wq = wid & 3, tid = wid * 64 + lane;
    const int q0 = qb * 128, qw0 = q0 + 32 * wq, qrow = qw0 + r32;
    const int NT = (MODE == 0) ? (q0 + 128) / 64 : 4;
    constexpr int NDB = (MODE == 0) ? 4 : 2;
    const bf16* Qp; const bf16* Kg0; const bf16* Kg1; const bf16* Vg0; const bf16* Vg1; int ldk;
    if (MODE == 0) { const bf16* pb_ = proj + (size_t)b * S * PLD; Qp = pb_ + (size_t)qrow * PLD + hh * 128 + mp * 64; Kg0 = pb_ + 768 + hh * 128; Kg1 = Kg0 + 64; Vg0 = pb_ + 1536 + hh * 128; Vg1 = Vg0; ldk = PLD; }
    else { const bf16* kb_ = kvm + (size_t)b * ML * 2048 + layer * 512; Qp = proj + ((size_t)b * S + qrow) * PLD + qoff + (hh * 2 + mp) * 64; Kg0 = kb_ + (hh * 2) * 64; Kg1 = Kg0 + 64; Vg0 = Kg0 + 256; Vg1 = Kg1 + 256; ldk = 2048; }
    const bf16* ks0 = Kg0 + (size_t)lane * ldk + wid * 8; const bf16* ks1 = Kg1 + (size_t)lane * ldk + wid * 8;
    const bf16* vs[2];
#pragma unroll
    for (int i = 0; i < 2; ++i) { const int pc = wid * 2 + i, rg = pc & 3;
        if (MODE == 0) vs[i] = Vg0 + (size_t)(16 * rg + (lane >> 2)) * ldk + (pc >> 2) * 32 + (lane & 3) * 8;
        else vs[i] = ((pc >> 3) ? Vg1 : Vg0) + (size_t)(16 * rg + (lane >> 2)) * ldk + ((pc >> 2) & 1) * 32 + (lane & 3) * 8; }
    const size_t tstep = (size_t)64 * ldk;
#define ATT_DMA(t, slot) do { LAS unsigned char* sb_ = lds + (slot) * SLOT; \
        __builtin_amdgcn_global_load_lds((const unsigned*)(ks0 + (size_t)(t) * tstep), (LAS unsigned*)(sb_ + L_K + wid * 1024), 16, 0, 0); \
        __builtin_amdgcn_global_load_lds((const unsigned*)(ks1 + (size_t)(t) * tstep), (LAS unsigned*)(sb_ + L_K + 8192 + wid * 1024), 16, 0, 0); \
        __builtin_amdgcn_global_load_lds((const unsigned*)(vs[0] + (size_t)(t) * tstep), (LAS unsigned*)(sb_ + L_V + wid * 2048), 16, 0, 0); \
        __builtin_amdgcn_global_load_lds((const unsigned*)(vs[1] + (size_t)(t) * tstep), (LAS unsigned*)(sb_ + L_V + wid * 2048 + 1024), 16, 0, 0); } while (0)
    ATT_DMA(0, 0);
    if (NT > 1) ATT_DMA(1, 1);
    LAS float* tb = (LAS float*)(lds + L_TB); LAS float* wsf = (LAS float*)(lds + L_WSF) + wid * 64;
    if (MODE == 0 && tid < 128) tb[tid] = (rel_bias[(int)BUCKET[tid] * 6 + hh] - rel_bias[31 * 6 + hh]) * LOG2E;
    bf16x8 qr[4];
#pragma unroll
    for (int d0 = 0; d0 < 4; ++d0) qr[d0] = *(const bf16x8*)(Qp + d0 * 16 + hi * 8);
    f32x16 o[NDB];
#pragma unroll
    for (int d0 = 0; d0 < NDB; ++d0) o[d0] = (f32x16){0.f, 0.f, 0.f, 0.f, 0.f, 0.f, 0.f, 0.f, 0.f, 0.f, 0.f, 0.f, 0.f, 0.f, 0.f, 0.f};
    float mref = -INFINITY, lsum = 0.f;
    f32x16 negm;
#pragma unroll
    for (int r = 0; r < 16; ++r) negm[r] = 0.f;
    const int koff = hi * 1024 + r32 * 16 + mp * 8192;
    const int voff = L_V + ((MODE == 1) ? mp * 8192 : 0) + ((lane >> 4) & 1) * 32 + (lane & 3) * 8 + (4 * hi + ((lane & 15) >> 2)) * 64;
    int slot = 0;
    for (int t = 0; t < NT; ++t) {
        if (t + 1 < NT) ATT_WAIT_BAR(4); else ATT_WAIT_BAR(0);
        if (t + 2 < NT) { const int s2 = (slot + 2 >= NSLOT) ? slot + 2 - NSLOT : slot + 2; ATT_DMA(t + 2, s2); }
        const LAS unsigned char* sb = lds + slot * SLOT;
        f32x16 p0, p1;
        {
            const LAS unsigned char* kp = sb + L_K + koff;
#pragma unroll
            for (int d0 = 0; d0 < 4; ++d0) {
                const bf16x8 k0 = *(const LAS bf16x8*)(kp + d0 * 2048), k1 = *(const LAS bf16x8*)(kp + d0 * 2048 + 512);
                p0 = ATT_MFMA(k0, qr[d0], d0 == 0 ? negm : p0); p1 = ATT_MFMA(k1, qr[d0], d0 == 0 ? negm : p1);
            }
        }
        if (MODE == 0) {
            if (64 * t + 63 + 112 >= qw0) {
                const int nb = qrow - 64 * t - 4 * hi;
#pragma unroll
                for (int r = 0; r < 16; ++r) { const int n0 = nb - ((r & 3) + 8 * (r >> 2)), n1 = n0 - 32;
                    const float b0 = tb[n0 < 0 ? 0 : (n0 > 127 ? 127 : n0)], b1 = tb[n1 < 0 ? 0 : (n1 > 127 ? 127 : n1)];
                    p0[r] = n0 < 0 ? -INFINITY : p0[r] + b0; p1[r] = n1 < 0 ? -INFINITY : p1[r] + b1; }
            }
        }
        float rm = fmaxf(p0[0], p1[0]);
#pragma unroll
        for (int r = 1; r < 16; ++r) rm = fmaxf(rm, fmaxf(p0[r], p1[r]));
        { auto rr = __builtin_amdgcn_permlane32_swap(__float_as_uint(rm), __float_as_uint(rm), false, false); rm = fmaxf(__uint_as_float(rr[0]), __uint_as_float(rr[1])); }
        const bool grow = (mref == -INFINITY) ? true : (rm > THR);
        if (__any(grow)) {
            const float dl = (mref == -INFINITY) ? rm : fmaxf(rm, 0.f);
            const float alpha = (mref == -INFINITY) ? 0.f : __builtin_amdgcn_exp2f(-dl);
            mref = (mref == -INFINITY) ? rm : mref + dl;
#pragma unroll
            for (int r = 0; r < 16; ++r) { p0[r] -= dl; p1[r] -= dl; negm[r] = -mref; }
            lsum *= alpha;
            if (hi == 0) wsf[r32] = alpha;
            asm volatile("s_waitcnt lgkmcnt(0)" ::: "memory");
#pragma unroll
            for (int r = 0; r < 16; ++r) { const float a = wsf[crow(r, hi)];
#pragma unroll
                for (int d0 = 0; d0 < NDB; ++d0) o[d0][r] *= a; }
        }
        float sacc = 0.f;
#pragma unroll
        for (int r = 0; r < 16; ++r) { p0[r] = __builtin_amdgcn_exp2f(p0[r]); p1[r] = __builtin_amdgcn_exp2f(p1[r]); sacc += p0[r] + p1[r]; }
        lsum += sacc;
        u32x4 pw[4];
#pragma unroll
        for (int k = 0; k < 4; ++k) { pw[0][k] = cvt_pk_bf16(p0[2 * k], p0[2 * k + 1]); pw[1][k] = cvt_pk_bf16(p0[8 + 2 * k], p0[9 + 2 * k]); pw[2][k] = cvt_pk_bf16(p1[2 * k], p1[2 * k + 1]); pw[3][k] = cvt_pk_bf16(p1[8 + 2 * k], p1[9 + 2 * k]); }
        {
            const LAS unsigned char* vp = sb + voff;
#pragma unroll
            for (int d0 = 0; d0 < NDB; ++d0)
#pragma unroll
                for (int ks = 0; ks < 4; ++ks) {
                    const s16x4 lo = __builtin_bit_cast(s16x4, __builtin_amdgcn_ds_read_tr16_b64_v4i16((LAS s16x4*)(vp + d0 * 4096 + ks * 1024)));
                    const s16x4 hv = __builtin_bit_cast(s16x4, __builtin_amdgcn_ds_read_tr16_b64_v4i16((LAS s16x4*)(vp + d0 * 4096 + ks * 1024 + 512)));
                    const bf16x8 vf = (bf16x8){lo[0], lo[1], lo[2], lo[3], hv[0], hv[1], hv[2], hv[3]};
                    o[d0] = ATT_MFMA(__builtin_bit_cast(bf16x8, pw[ks]), vf, o[d0]);
                }
        }
        slot = (slot + 1 >= NSLOT) ? 0 : slot + 1;
    }
    { auto rr = __builtin_amdgcn_permlane32_swap(__float_as_uint(lsum), __float_as_uint(lsum), false, false); lsum = __uint_as_float(rr[0]) + __uint_as_float(rr[1]); }
    if (hi == 0) wsf[32 + r32] = 1.0f / lsum;
    asm volatile("s_waitcnt lgkmcnt(0)" ::: "memory");
#pragma unroll
    for (int r = 0; r < 16; ++r) { const float a = wsf[32 + crow(r, hi)];
#pragma unroll
        for (int d0 = 0; d0 < NDB; ++d0) o[d0][r] *= a; }
    ATT_WAIT_BAR(0);
    if (MODE == 0) {
        LAS float* X = (LAS float*)(lds + L_X);
        if (mp == 1) {
#pragma unroll
            for (int d0 = 0; d0 < 4; ++d0)
#pragma unroll
                for (int r = 0; r < 16; ++r) X[((wq * 4 + d0) * 16 + r) * 64 + lane] = o[d0][r];
        }
        ATT_WAIT_BAR(0);
        if (mp == 0) {
            float ss[16];
#pragma unroll
            for (int r = 0; r < 16; ++r) { float a = 0.f;
#pragma unroll
                for (int d0 = 0; d0 < 4; ++d0) { const float v = o[d0][r] - lam * X[((wq * 4 + d0) * 16 + r) * 64 + lane]; o[d0][r] = v; a += v * v; }
                ss[r] = a; }
#pragma unroll
            for (int off = 1; off < 32; off <<= 1)
#pragma unroll
                for (int r = 0; r < 16; ++r) ss[r] += __shfl_xor(ss[r], off);
            float gd[4];
#pragma unroll
            for (int d0 = 0; d0 < 4; ++d0) gd[d0] = subg[d0 * 32 + r32] * (1.0f - lambda_init);
            LAS bf16* ost = (LAS bf16*)(lds + L_OST) + wq * 4096;
#pragma unroll
            for (int r = 0; r < 16; ++r) { const float rn = rsqrtf(ss[r] * (1.0f / 128.0f) + EPS); const int row = crow(r, hi);
#pragma unroll
                for (int d0 = 0; d0 < 4; ++d0) ost[row * 128 + d0 * 32 + r32] = (bf16)(cvt_pk_bf16(o[d0][r] * rn * gd[d0], 0.f) & 0xffffu); }
            asm volatile("s_waitcnt lgkmcnt(0)" ::: "memory");
            bf16* op = cat + ((size_t)b * S + qw0) * D + hh * 128;
#pragma unroll
            for (int i = 0; i < 8; ++i) { const int c = i * 64 + lane, row = c >> 4, ch = c & 15; *(u32x4*)(op + (size_t)row * D + ch * 8) = *(const LAS u32x4*)(ost + row * 128 + ch * 8); }
        }
    } else {
        LAS bf16* ost = (LAS bf16*)(lds + L_OST) + wid * 2048;
#pragma unroll
        for (int r = 0; r < 16; ++r) { const int row = crow(r, hi);
#pragma unroll
            for (int d0 = 0; d0 < 2; ++d0) ost[row * 64 + d0 * 32 + r32] = (bf16)(cvt_pk_bf16(o[d0][r], 0.f) & 0xffffu); }
        asm volatile("s_waitcnt lgkmcnt(0)" ::: "memory");
        bf16* op = cat + ((size_t)b * S + qw0) * D + TW + (hh * 2 + mp) * 64;
#pragma unroll
        for (int i = 0; i < 4; ++i) { const int c = i * 64 + lane, row = c >> 3, ch = c & 7; *(u32x4*)(op + (size_t)row * D + ch * 8) = *(const LAS u32x4*)(ost + row * 64 + ch * 8); }
    }
    ATT_WAIT_BAR(0);
#undef ATT_DMA
}
__device__ __forceinline__ void attn_phase(LAS unsigned char* lds, const int wave, const bool diff, unsigned* qctr, volatile LAS unsigned* qword,
                                           const bf16* proj, const bf16* kvm, const int layer, const int qoff, const float* rel_bias, const float* lq1, const float* lk1, const float* lq2, const float* lk2,
                                           const float* subg, const float lambda_init, bf16* cat) {
    float lam = 0.f;
    if (diff) { const int l = lane_id(); lam = __expf(wave_sum(lq1[l] * lk1[l])) - __expf(wave_sum(lq2[l] * lk2[l])) + lambda_init; }
    const int ndiff = diff ? NB * 6 * (S / 128) : 0, ntot = ndiff + NB * 2 * (S / 128);
    for (;;) {
        if (wave == 0 && lane_id() == 0) qword[0] = __hip_atomic_fetch_add(qctr, 1u, __ATOMIC_RELAXED, __HIP_MEMORY_SCOPE_AGENT);
        __syncthreads();
        const int u = __builtin_amdgcn_readfirstlane((int)qword[0]);
        if (u >= ntot) break;
        if (u < ndiff) { const int bh = u % 12; attn_unit<0>(lds, wave, bh / 6, bh % 6, 63 - u / 12, proj, kvm, layer, qoff, rel_bias, subg, lam, lambda_init, cat); }
        else { const int v = u - ndiff; attn_unit<1>(lds, wave, v >> 7, (v >> 6) & 1, v & 63, proj, kvm, layer, qoff, rel_bias, subg, lam, lambda_init, cat); }
    }
    __syncthreads();
}
#undef ATT_WAIT_BAR
#undef ATT_MFMA
}

constexpr int GT_TABA = LDSCTL_OFF + 4096, GT_TABS = LDSCTL_OFF + 6144;
constexpr int RT_TAB = LDSCTL_OFF + 1024;
__device__ __forceinline__ void route_phase(LAS unsigned char* lds, const int wave, const float* h, const float* g, const float* wg, const float* wr, bf16* hn, unsigned* gcnt, int* list, float* ew, int G, int bx) {
    const int lane = lane_id(), tid = wave * 64 + lane;
    LAS float* WL = (LAS float*)lds;
    LAS int* lcnt = (LAS int*)(lds + RT_TAB); LAS int* lbase = lcnt + 16; LAS int* rinfo = lcnt + 32; LAS float* rw = (LAS float*)(lcnt + 32 + 256);
    for (int idx = tid; idx < 20 * D; idx += NTHR) { const int o = idx >> 10, d = idx & 1023; WL[idx] = (o < 4) ? wg[d * 4 + o] : wr[d * 16 + (o - 4)]; }
    __syncthreads();
    for (int ck = bx; ck < T / 64; ck += G) {
        if (tid < 16) lcnt[tid] = 0;
        __syncthreads();
        for (int it = 0; it < 4; ++it) {
            const int r0 = wave * 8 + it * 2; const size_t m0 = (size_t)ck * 64 + r0;
            f32x4 v0[4], v1[4]; float ss0 = 0.f, ss1 = 0.f;
#pragma unroll
            for (int j = 0; j < 4; ++j) { v0[j] = ((const f32x4*)(h + m0 * D))[64 * j + lane]; v1[j] = ((const f32x4*)(h + (m0 + 1) * D))[64 * j + lane];
                ss0 += (v0[j][0] * v0[j][0] + v0[j][1] * v0[j][1]) + (v0[j][2] * v0[j][2] + v0[j][3] * v0[j][3]);
                ss1 += (v1[j][0] * v1[j][0] + v1[j][1] * v1[j][1]) + (v1[j][2] * v1[j][2] + v1[j][3] * v1[j][3]); }
            const float rs0 = rsqrtf(wave_sum(ss0) * (1.0f / D) + EPS), rs1 = rsqrtf(wave_sum(ss1) * (1.0f / D) + EPS);
#pragma unroll
            for (int j = 0; j < 4; ++j) { const f32x4 gg = ((const f32x4*)g)[64 * j + lane]; v0[j] = v0[j] * rs0 * gg; v1[j] = v1[j] * rs1 * gg;
                u32x2 w; w.x = cvt_pk_bf16(v0[j][0], v0[j][1]); w.y = cvt_pk_bf16(v0[j][2], v0[j][3]); ((u32x2*)(hn + m0 * D))[64 * j + lane] = w;
                w.x = cvt_pk_bf16(v1[j][0], v1[j][1]); w.y = cvt_pk_bf16(v1[j][2], v1[j][3]); ((u32x2*)(hn + (m0 + 1) * D))[64 * j + lane] = w; }
            float a0[20], a1[20];
#pragma unroll
            for (int o = 0; o < 20; ++o) { float s0 = 0.f, s1 = 0.f;
#pragma unroll
                for (int j = 0; j < 4; ++j) { const f32x4 w4 = *(const LAS f32x4*)(WL + o * D + 256 * j + 4 * lane);
                    s0 += (v0[j][0] * w4[0] + v0[j][1] * w4[1]) + (v0[j][2] * w4[2] + v0[j][3] * w4[3]);
                    s1 += (v1[j][0] * w4[0] + v1[j][1] * w4[1]) + (v1[j][2] * w4[2] + v1[j][3] * w4[3]); }
                a0[o] = wave_sum(s0); a1[o] = wave_sum(s1); }
#pragma unroll
            for (int rr = 0; rr < 2; ++rr) {
                float acc[20];
#pragma unroll
                for (int o = 0; o < 20; ++o) acc[o] = rr ? a1[o] : a0[o];
                int gi = 0; float gm = acc[0];
#pragma unroll
                for (int o = 1; o < 4; ++o) if (acc[o] > gm) { gm = acc[o]; gi = o; }
                float gs = 0.f;
#pragma unroll
                for (int o = 0; o < 4; ++o) gs += __expf(acc[o] - gm);
                const float gwt = 1.0f / gs;
                float e[4];
#pragma unroll
                for (int k = 0; k < 4; ++k) { e[k] = acc[4 + k];
#pragma unroll
                    for (int q = 1; q < 4; ++q) if (gi == q) e[k] = acc[4 + q * 4 + k]; }
                int i1 = 0; float x1 = e[0];
#pragma unroll
                for (int k = 1; k < 4; ++k) if (e[k] > x1) { x1 = e[k]; i1 = k; }
                int i2 = 0; float x2 = -INFINITY;
#pragma unroll
                for (int k = 0; k < 4; ++k) if (k != i1 && e[k] > x2) { x2 = e[k]; i2 = k; }
                const float ex = __expf(x2 - x1); const float w1 = gwt / (1.0f + ex), w2 = w1 * ex;
                if (lane == 0) { const int e0 = gi * 4 + i1, e1 = gi * 4 + i2, rl = r0 + rr;
                    const int k0 = __hip_atomic_fetch_add(lcnt + e0, 1, __ATOMIC_RELAXED, __HIP_MEMORY_SCOPE_WORKGROUP);
                    const int k1 = __hip_atomic_fetch_add(lcnt + e1, 1, __ATOMIC_RELAXED, __HIP_MEMORY_SCOPE_WORKGROUP);
                    rinfo[rl * 4] = e0; rinfo[rl * 4 + 1] = k0; rinfo[rl * 4 + 2] = e1; rinfo[rl * 4 + 3] = k1; rw[rl * 2] = w1; rw[rl * 2 + 1] = w2; }
            }
        }
        __syncthreads();
        if (tid < 16) { const int cn = lcnt[tid]; lbase[tid] = cn ? (int)__hip_atomic_fetch_add(gcnt + tid, (unsigned)cn, __ATOMIC_RELAXED, __HIP_MEMORY_SCOPE_AGENT) : 0; }
        __syncthreads();
        if (tid < 64) { const int t = ck * 64 + tid; const int e0 = rinfo[tid * 4], k0 = rinfo[tid * 4 + 1], e1 = rinfo[tid * 4 + 2], k1 = rinfo[tid * 4 + 3];
            list[(size_t)e0 * T + lbase[e0] + k0] = 2 * t; list[(size_t)e1 * T + lbase[e1] + k1] = 2 * t + 1; ew[2 * t] = rw[tid * 2]; ew[2 * t + 1] = rw[tid * 2 + 1]; }
        __syncthreads();
    }
}
__device__ __forceinline__ void moe_table(LAS unsigned char* lds, unsigned* gcnt, bool leader) {
    LAS int* tab = (LAS int*)(lds + RT_TAB);
    if (leader) { int pre = 0;
        for (int e = 0; e < 16; ++e) { const int cn = (int)__hip_atomic_load(gcnt + e, __ATOMIC_RELAXED, __HIP_MEMORY_SCOPE_AGENT); tab[e] = cn; tab[16 + e] = pre; pre += (cn + 255) >> 8; }
        tab[32] = pre; }
    __syncthreads();
}

__global__ void __launch_bounds__(NTHR, 2) mega(Args args) {
    extern __shared__ __attribute__((aligned(16))) unsigned char lds_raw[];
    LAS unsigned char* lds = (LAS unsigned char*)lds_raw;
    const int wave = __builtin_amdgcn_readfirstlane(threadIdx.x >> 6);
#define TID() (wave * 64 + lane_id())
#define LEADER() (wave == 0 && lane_id() == 0)
    const int G = gridDim.x, bx = blockIdx.x;
    unsigned char* ws = args.ws;
    unsigned* ctl = (unsigned*)(ws + WS_CTL);
    for (int u = TID(); u < (LDS_BYTES - LDSCTL_OFF) / 4; u += NTHR) ((LAS unsigned*)(lds + LDSCTL_OFF))[u] = 0u;
    __syncthreads();
    volatile LAS unsigned* MISC = (volatile LAS unsigned*)(lds + LDSCTL_OFF + 320);
    const unsigned phm = (unsigned)args.ph_mask, sem = (unsigned)args.seam_mask;
    XcdBarrier bar; bar.bar = ctl + CW_BAR + args.li * XCD_BAR_WORDS; bar.x = 0; bar.st = nullptr;
    if (sem) bar = xcd_barrier_post(ctl + CW_BAR + args.li * XCD_BAR_WORDS, MISC + 8, LEADER());
#ifndef PHASE_MASK
#define PHASE_MASK 0xffff
#endif
#define IN(k) (((PHASE_MASK >> (k)) & 1) && ((phm >> (k)) & 1u))
#define SEAM(k) do { if ((sem >> (k)) & 1u) xcd_barrier(bar, LEADER()); } while (0)
    const int gw = bx * NWAVES + wave, NGW = G * NWAVES;
    float* h = args.out;
    bf16* hn = (bf16*)(ws + WS_HN); bf16* cat = (bf16*)(ws + WS_CAT); bf16* proj = (bf16*)(ws + WS_PROJ);
    bf16* memn = (bf16*)(ws + WS_MEMN); bf16* kvm = (bf16*)(ws + WS_KVM); bf16* wkv = (bf16*)(ws + WS_WKV);
    bf16* gwt = (bf16*)(ws + WS_GW); float* gpar = (float*)(ws + WS_GP);
    bf16* hid = (bf16*)(ws + WS_HID); bf16* y2 = (bf16*)(ws + WS_Y2); int* list = (int*)(ws + WS_LIST); float* ew = (float*)(ws + WS_EW);
    float* sumA = (float*)(ws + WS_SUM); float* sumB = sumA + (size_t)NB * RG_NCH * TW;

    if (IN(K_PRO)) {
        LAS float* scr = (LAS float*)(lds + wave * 16384);
        for (int i = 0; i < 4; ++i) {
            const int j = i >> 1, nin = (i & 1) ? INB : INA, n_win = 16 * (nin / 32);
            const int n_items = n_win + 512 + 256 + 3 * 2048;
            unsigned char* wl = ws + WS_W + (size_t)i * W_LAYER;
            const float* win = (i & 1) ? args.in[I_WINB] + (size_t)j * D * INB : args.in[I_WINA] + (size_t)j * D * INA;
            for (int it = gw; it < n_items; it += NGW) {
                int r = it;
                if (r < n_win) { const int nblk = nin / 32, kb = r / nblk, nb = r % nblk, n0 = 32 * nb;
                    const bool isq = (i & 1) ? (n0 < 768 || n0 >= 2304) : (n0 >= 1536);
                    transpose_item(win, nin, 64 * kb, n0, (bf16*)(wl + W_IN), D, n0, isq ? 0.125f * att::LOG2E : 1.0f, scr, lane_id()); continue; } r -= n_win;
                if (r < 512) { const int kb = r / 32, nb = r % 32; transpose_item(args.in[I_WOUT] + (size_t)i * D * D, D, 64 * kb, 32 * nb, (bf16*)(wl + W_OUT), D, 32 * nb, 1.0f, scr, lane_id()); continue; } r -= 512;
                if (r < 256) { const int kb = r / 16, nb = r % 16; transpose_item(args.in[I_WKV] + (size_t)i * D * 512, 512, 64 * kb, 32 * nb, wkv, D, i * 512 + 32 * nb, 1.0f, scr, lane_id()); continue; } r -= 256;
                if (r < 4096) {
                    const int which = r / 2048, rr = r % 2048, e = rr / 128, q = rr % 128, kb = q / 8, nb = q % 8, n0 = 32 * nb;
                    const float* src = (which ? args.in[I_W3] : args.in[I_W1]) + ((size_t)i * NE + e) * D * DE;
                    transpose_item(src, DE, 64 * kb, n0, (bf16*)(wl + W_13) + (size_t)e * 512 * D, D, 256 * (n0 / 128) + 128 * which + (n0 % 128), 1.0f, scr, lane_id()); continue; } r -= 4096;
                { const int e = r / 128, q = r % 128, kb = q / 32, nb = q % 32;
                    transpose_item(args.in[I_W2] + ((size_t)i * NE + e) * DE * D, D, 64 * kb, 32 * nb, (bf16*)(wl + W_2) + (size_t)e * D * DE, DE, 32 * nb, 1.0f, scr, lane_id()); }
            }
        }
        for (int idx = bx * NTHR + TID(); idx < 2 * 2 * 8 * 96 * 96; idx += G * NTHR) {
            const int k = idx % 96, n = (idx / 96) % 96, g = (idx / 9216) % 8, gate = (idx / 73728) % 2, j = idx / 147456;
            const float* src = (gate ? args.in[I_GXW] : args.in[I_GAW]) + (size_t)j * 8 * 9216;
            gwt[idx] = (bf16)(cvt_pk_bf16(src[(g * 96 + k) * 96 + n], 0.f) & 0xffffu);
        }
        for (int idx = bx * NTHR + TID(); idx < 2 * TW; idx += G * NTHR) {
            const int j = idx / TW, c = idx % TW;
            gpar[(j * 3 + 0) * TW + c] = args.in[I_GAB][idx]; gpar[(j * 3 + 1) * TW + c] = args.in[I_GXB][idx];
            const float nl = -args.in[I_LAM][idx];
            gpar[(j * 3 + 2) * TW + c] = -8.0f * (fmaxf(nl, 0.f) + log1pf(expf(-fabsf(nl))));
        }
        for (int m = gw; m < NB * ML; m += NGW) norm_row(args.in[I_MEM] + (size_t)m * D, nullptr, nullptr, nullptr, args.in[I_MNG], memn + (size_t)m * D, nullptr, lane_id());
    }
    SEAM(K_PRO);
    if (IN(K_KVM)) {
        pg8::DenseSched Sd; Sd.init(memn, wkv, NB * ML, 4 * 512, D, G, bx);
        pg8::EpiStoreBf16 E{kvm, 4 * 512};
        pg8::gemm_phase<pg8::EpiStoreBf16, pg8::DenseSched, true>(lds, wave, D, Sd, E);
    }
    SEAM(K_KVM);

    for (int i = args.l_lo; i < args.l_hi; ++i) {
        const int j = i >> 1;
        unsigned char* wl = ws + WS_W + (size_t)i * W_LAYER;
        if (IN(K_N1)) {
            if (i == 0) { for (int m = gw; m < T; m += NGW) norm_row(args.in[I_X] + (size_t)m * D, nullptr, nullptr, nullptr, args.in[I_NMG] + i * D, hn + (size_t)m * D, nullptr, lane_id()); }
            else { for (int m = gw; m < T; m += NGW) norm_row(h + (size_t)m * D, y2 + (size_t)(2 * m) * D, y2 + (size_t)(2 * m + 1) * D, h + (size_t)m * D, args.in[I_NMG] + i * D, hn + (size_t)m * D, nullptr, lane_id()); }
        }
        SEAM(K_N1);
        if (IN(K_G1)) {
            pg8::DenseSched Sd; Sd.init(hn, (const bf16*)(wl + W_IN), T, (i & 1) ? INB : INA, D, G, bx);
            pg8::EpiStoreBf16 E{proj, PLD};
            pg8::gemm_phase<pg8::EpiStoreBf16, pg8::DenseSched, true>(lds, wave, D, Sd, E);
        }
        SEAM(K_G1);
        if (IN(K_M1) && (i & 1)) {
            const float lambda_init = 0.8f - 0.6f * __expf(-0.3f * (float)i);
            att::attn_phase(lds, wave, true, ctl + CW_AQ + 64 * i, MISC + 16, proj, kvm, i, 2304, args.in[I_RELB], args.in[I_LQ1] + j * 64, args.in[I_LK1] + j * 64, args.in[I_LQ2] + j * 64, args.in[I_LK2] + j * 64,
                            args.in[I_SUBG] + j * 128, lambda_init, cat);
        }
        if ((i & 1) == 0) {
            if (IN(K_M1)) {
                for (int u = bx; u < NB * RG_NCH * 8; u += G)
                    rglru_unit<1>(lds, wave, u / (RG_NCH * 8), (u / 8) % RG_NCH, u % 8, proj, args.in[I_CW] + (size_t)j * 4 * TW, args.in[I_CB] + j * TW, gwt + (size_t)j * 2 * 8 * 9216, gpar + (size_t)j * 3 * TW, sumA, sumB, cat);
            }
            if (IN(K_M1)) att::attn_phase(lds, wave, false, ctl + CW_AQ + 64 * i, MISC + 16, proj, kvm, i, 1536, nullptr, nullptr, nullptr, nullptr, nullptr, nullptr, 0.f, cat);
            SEAM(K_M1);
            if (IN(K_M2)) {
                for (int u = bx; u < NB * RG_NCH * 8; u += G)
                    rglru_unit<2>(lds, wave, u / (RG_NCH * 8), (u / 8) % RG_NCH, u % 8, proj, args.in[I_CW] + (size_t)j * 4 * TW, args.in[I_CB] + j * TW, gwt + (size_t)j * 2 * 8 * 9216, gpar + (size_t)j * 3 * TW, sumA, sumB, cat);
            }
            SEAM(K_M2);
        } else { SEAM(K_M1); }
        if (IN(K_G2)) {
            pg8::DenseSched Sd; Sd.init(cat, (const bf16*)(wl + W_OUT), T, D, D, G, bx);
            pg8::EpiResF32 E{(i == 0) ? args.in[I_X] : h, h, D};
            pg8::gemm_phase<pg8::EpiResF32, pg8::DenseSched, true>(lds, wave, D, Sd, E);
        }
        SEAM(K_G2);
        if (IN(K_N2)) route_phase(lds, wave, h, args.in[I_NFG] + i * D, args.in[I_WG] + (size_t)i * D * 4, args.in[I_WR] + (size_t)i * D * 16, hn, ctl + CW_CNT + 64 * i, list, ew, G, bx);
        SEAM(K_N2);
        if (IN(K_E1)) {
            moe_table(lds, ctl + CW_CNT + 64 * i, LEADER());
            pg8::MoeSched Sm{hn, (const bf16*)(wl + W_13), D, (size_t)512 * D * 2, 2, 1, list, (const LAS int*)(lds + RT_TAB), (LAS int*)(lds + GT_TABS), G, bx};
            pg8::EpiMoe1 E{hid, (const LAS int*)(lds + GT_TABS), ew};
            pg8::gemm_phase<pg8::EpiMoe1, pg8::MoeSched, true>(lds, wave, D, Sm, E);
        }
        SEAM(K_E1);
        if (IN(K_E2)) {
            moe_table(lds, ctl + CW_CNT + 64 * i, LEADER());
            pg8::MoeSched Sm{hid, (const bf16*)(wl + W_2), DE, (size_t)D * DE * 2, 4, 0, list, (const LAS int*)(lds + RT_TAB), (LAS int*)(lds + GT_TABS), G, bx};
            pg8::EpiMoe2 E{y2, (const LAS int*)(lds + GT_TABS)};
            pg8::gemm_phase<pg8::EpiMoe2, pg8::MoeSched, true>(lds, wave, DE, Sm, E);
        }
        SEAM(K_E2);
    }
    if (IN(K_FIN)) {
        for (int m = gw; m < T; m += NGW) norm_row(h + (size_t)m * D, y2 + (size_t)(2 * m) * D, y2 + (size_t)(2 * m + 1) * D, nullptr, args.in[I_FNG], nullptr, h + (size_t)m * D, lane_id());
    }
#undef IN
#undef SEAM
#undef TID
#undef LEADER
}

namespace naive {
template <int DV>
__device__ __forceinline__ void attn_row(float qv, const bf16* Kb, int ldk, const bf16* Vb, int ldv, int nkeys, int qpos, const float* bias, float (&o)[DV / 64]) {
    const int lane = threadIdx.x & 63;
    float m = -INFINITY, l = 0.f;
#pragma unroll
    for (int i = 0; i < DV / 64; ++i) o[i] = 0.f;
    for (int c0 = 0; c0 < nkeys; c0 += 64) {
        const int j = c0 + lane; const bool valid = j < nkeys;
        const bf16* kr = Kb + (size_t)(valid ? j : 0) * ldk;
        float acc = 0.f;
        for (int d = 0; d < 64; ++d) acc += __shfl(qv, d) * bf2f(kr[d]);
        float s = acc * 0.125f;
        if (bias) { int n = qpos - j; n = n < 0 ? 0 : (n > 127 ? 127 : n); s += bias[(int)BUCKET[n] * 6]; }
        if (!valid) s = -INFINITY;
        const float mn = fmaxf(m, wave_max(s));
        const float p = valid ? expf(s - mn) : 0.f;
        const float alpha = expf(m - mn);
        l = l * alpha + wave_sum(p);
#pragma unroll
        for (int i = 0; i < DV / 64; ++i) o[i] *= alpha;
        const int cnt = (nkeys - c0) < 64 ? (nkeys - c0) : 64;
        for (int jj = 0; jj < cnt; ++jj) {
            const float pj = __shfl(p, jj); const bf16* vr = Vb + (size_t)(c0 + jj) * ldv;
#pragma unroll
            for (int i = 0; i < DV / 64; ++i) o[i] += pj * bf2f(vr[lane + 64 * i]);
        }
        m = mn;
    }
    const float inv = 1.0f / l;
#pragma unroll
    for (int i = 0; i < DV / 64; ++i) o[i] *= inv;
}
__global__ void __launch_bounds__(256) k_diffattn(const bf16* proj, const float* rel_bias, const float* lq1, const float* lk1, const float* lq2, const float* lk2,
                                                 const float* subg, float lambda_init, bf16* cat) {
    const int lane = threadIdx.x & 63, r = blockIdx.x * 4 + (threadIdx.x >> 6);
    const int s = r % S, bh = r / S, hh = bh % 6, b = bh / 6;
    const size_t t = (size_t)b * S + s;
    const float e1 = expf(wave_sum(lq1[lane] * lk1[lane])), e2 = expf(wave_sum(lq2[lane] * lk2[lane]));
    const float lam = e1 - e2 + lambda_init;
    float om0[2], om1[2];
    const bf16* Vb = proj + (size_t)b * S * PLD + 1536 + hh * 128;
    attn_row<128>(bf2f(proj[t * PLD + hh * 128 + lane]), proj + (size_t)b * S * PLD + 768 + hh * 128, PLD, Vb, PLD, s + 1, s, rel_bias + hh, om0);
    attn_row<128>(bf2f(proj[t * PLD + hh * 128 + 64 + lane]), proj + (size_t)b * S * PLD + 768 + hh * 128 + 64, PLD, Vb, PLD, s + 1, s, rel_bias + hh, om1);
    float o[2]; o[0] = om0[0] - lam * om1[0]; o[1] = om0[1] - lam * om1[1];
    const float ss = wave_sum(o[0] * o[0] + o[1] * o[1]);
    const float rr = rsqrtf(ss * (1.0f / 128.0f) + EPS) * (1.0f - lambda_init);
    cat[t * D + hh * 128 + lane] = (bf16)(cvt_pk_bf16(o[0] * rr * subg[lane], 0.f) & 0xffffu);
    cat[t * D + hh * 128 + 64 + lane] = (bf16)(cvt_pk_bf16(o[1] * rr * subg[64 + lane], 0.f) & 0xffffu);
}
__global__ void __launch_bounds__(256) k_memattn(const bf16* proj, int qoff, const bf16* kvm, int layer, bf16* cat) {
    const int lane = threadIdx.x & 63, r = blockIdx.x * 4 + (threadIdx.x >> 6);
    const int hd = r & 3; const size_t t = (size_t)(r >> 2); const int b = (int)(t / S);
    const float qv = bf2f(proj[t * PLD + qoff + hd * 64 + lane]);
    float o[1];
    const bf16* kb = kvm + (size_t)b * ML * 2048 + layer * 512 + hd * 64;
    attn_row<64>(qv, kb, 2048, kb + 256, 2048, ML, 0, nullptr, o);
    cat[t * D + TW + hd * 64 + lane] = (bf16)(cvt_pk_bf16(o[0], 0.f) & 0xffffu);
}
__global__ void __launch_bounds__(256) k_route(const float* hres, const float* gn, const float* wg, const float* wr, int* eid, float* ew) {
    const int lane = threadIdx.x & 63; const size_t t = (size_t)blockIdx.x * 4 + (threadIdx.x >> 6);
    float acc[20];
#pragma unroll
    for (int o = 0; o < 20; ++o) acc[o] = 0.f;
    float ssq = 0.f;
    for (int d = lane; d < D; d += 64) { const float x = hres[t * D + d]; ssq += x * x; }
    const float rstd = rsqrtf(wave_sum(ssq) * (1.0f / D) + EPS);
    for (int d = lane; d < D; d += 64) {
        const float x = hres[t * D + d] * rstd * gn[d];
#pragma unroll
        for (int o = 0; o < 4; ++o) acc[o] += x * wg[d * 4 + o];
#pragma unroll
        for (int o = 0; o < 16; ++o) acc[4 + o] += x * wr[d * 16 + o];
    }
#pragma unroll
    for (int o = 0; o < 20; ++o) acc[o] = wave_sum(acc[o]);
    int gi = 0; float gm = acc[0];
#pragma unroll
    for (int o = 1; o < 4; ++o) if (acc[o] > gm) { gm = acc[o]; gi = o; }
    float gs = 0.f;
#pragma unroll
    for (int o = 0; o < 4; ++o) gs += expf(acc[o] - gm);
    const float gwt = 1.0f / gs;
    float e[4];
#pragma unroll
    for (int k = 0; k < 4; ++k) { e[k] = acc[4 + k];
#pragma unroll
        for (int g = 1; g < 4; ++g) if (gi == g) e[k] = acc[4 + g * 4 + k]; }
    int i1 = 0; float v1 = e[0];
#pragma unroll
    for (int k = 1; k < 4; ++k) if (e[k] > v1) { v1 = e[k]; i1 = k; }
    int i2 = -1; float v2 = -INFINITY;
#pragma unroll
    for (int k = 0; k < 4; ++k) if (k != i1 && e[k] > v2) { v2 = e[k]; i2 = k; }
    const float ex = expf(v2 - v1);
    const float w1 = 1.0f / (1.0f + ex), w2 = ex / (1.0f + ex);
    if (lane == 0) { eid[t * 2] = gi * 4 + i1; eid[t * 2 + 1] = gi * 4 + i2; ew[t * 2] = w1 * gwt; ew[t * 2 + 1] = w2 * gwt; }
}
__global__ void __launch_bounds__(256) k_moe(const bf16* hn, const int* eid, const float* ew, const float* w1, const float* w3, const float* w2, float* h) {
    __shared__ float st[D];
    __shared__ float hid[DE];
    const int tid = threadIdx.x; const size_t t = blockIdx.x;
    for (int d = tid; d < D; d += 256) st[d] = bf2f(hn[t * D + d]);
    __syncthreads();
    float y[4] = {0.f, 0.f, 0.f, 0.f};
    for (int sidx = 0; sidx < 2; ++sidx) {
        const int e = eid[t * 2 + sidx]; const float wgt = ew[t * 2 + sidx];
        const float* p1 = w1 + (size_t)e * D * DE + tid; const float* p3 = w3 + (size_t)e * D * DE + tid;
        float a = 0.f, u = 0.f;
        for (int d = 0; d < D; ++d) { const float x = st[d]; a += x * p1[(size_t)d * DE]; u += x * p3[(size_t)d * DE]; }
        hid[tid] = (a / (1.0f + expf(-a))) * u * wgt;
        __syncthreads();
        const float* p2 = w2 + (size_t)e * DE * D + tid;
        for (int jx = 0; jx < DE; ++jx) { const float hv = hid[jx];
#pragma unroll
            for (int i = 0; i < 4; ++i) y[i] += hv * p2[(size_t)jx * D + 256 * i]; }
        __syncthreads();
    }
#pragma unroll
    for (int i = 0; i < 4; ++i) h[t * D + tid + 256 * i] += y[i];
}
}

extern "C" void kernel_launch(void* const* d_in, const int* in_sizes, int n_in, void* d_out, int out_size, void* d_ws, size_t ws_size, hipStream_t stream) {
    static int grid = 0;
    if (grid == 0) {
        if (n_in != 28 || out_size != T * D || ws_size < WS_END) { fprintf(stderr, "kernel_launch: unexpected n_in %d / out_size %d / ws_size %zu\n", n_in, out_size, ws_size); grid = -1; return; }
        int dev = 0, cus = 0, per_cu = 0;
        if (hipGetDevice(&dev) != hipSuccess || hipDeviceGetAttribute(&cus, hipDeviceAttributeMultiprocessorCount, dev) != hipSuccess) { grid = -1; return; }
        if (hipFuncSetAttribute((const void*)mega, hipFuncAttributeMaxDynamicSharedMemorySize, LDS_BYTES) != hipSuccess) { fprintf(stderr, "kernel_launch: hipFuncSetAttribute failed\n"); grid = -1; return; }
        if (hipOccupancyMaxActiveBlocksPerMultiprocessor(&per_cu, (const void*)mega, NTHR, LDS_BYTES) != hipSuccess || per_cu < 1) fprintf(stderr, "kernel_launch: occupancy query says %d\n", per_cu);
        (void)hipGetLastError();
        grid = cus;
    }
    if (grid < 0) return;
    (void)hipMemsetAsync((char*)d_ws + WS_CTL, 0, CTL_ZERO_BYTES, stream);
    Args a{};
    for (int i = 0; i < 28; ++i) a.in[i] = (const float*)d_in[i];
    a.out = (float*)d_out; a.ws = (unsigned char*)d_ws;
    unsigned char* ws = (unsigned char*)d_ws;
    int li = 0;
    auto run = [&](int l_lo, int l_hi, unsigned phm, unsigned sem) { a.l_lo = l_lo; a.l_hi = l_hi; a.ph_mask = (int)phm; a.seam_mask = (int)sem; a.li = li++; hipLaunchKernelGGL(mega, dim3(grid), dim3(NTHR), LDS_BYTES, stream, a); };
#define KB(k) (1u << (k))
    const bf16* proj = (const bf16*)(ws + WS_PROJ); bf16* cat = (bf16*)(ws + WS_CAT); const bf16* hn = (const bf16*)(ws + WS_HN); const bf16* kvm = (const bf16*)(ws + WS_KVM);
    int* eid = (int*)(ws + WS_EID); float* ew = (float*)(ws + WS_EW);
    run(0, 0, KB(K_PRO) | KB(K_KVM), KB(K_PRO));
    for (int i = 0; i < 4; ++i) {
        const int j = i / 2;
        run(i, i + 1, KB(K_N1) | KB(K_G1), KB(K_N1));
        if ((i & 1) == 0) run(i, i + 1, KB(K_M1) | KB(K_M2), KB(K_M1));
        else run(i, i + 1, KB(K_M1), 0);
        run(i, i + 1, KB(K_G2) | KB(K_N2) | KB(K_E1) | KB(K_E2), KB(K_G2) | KB(K_N2) | KB(K_E1));
    }
    run(0, 0, KB(K_FIN), 0);
}
```

```cpp
#include <hip/hip_runtime.h>
#include <math.h>
#include <stdio.h>
#include <stdint.h>

#define LAS __attribute__((address_space(3)))
#define GAS __attribute__((address_space(1)))
typedef unsigned short bf16;
typedef short bf16x8 __attribute__((ext_vector_type(8)));
typedef float f32x4 __attribute__((ext_vector_type(4)));
typedef unsigned u32x4 __attribute__((ext_vector_type(4)));
typedef unsigned u32x2 __attribute__((ext_vector_type(2)));

constexpr int D = 1024, NB = 2, S = 8192, T = NB * S, ML = 256, TW = 768, INA = 1792, INB = 2560, DE = 256, NE = 16;
constexpr int PLD = 2560;
constexpr float EPS = 1e-6f;
constexpr int NWAVES = 8, NTHR = 512;

constexpr size_t MiB = 1u << 20;
constexpr size_t WS_CTL = 0, CTL_ZERO_BYTES = 65536;
constexpr size_t WS_W = 2 * MiB, W_LAYER = 31 * MiB, W_IN = 0, W_OUT = 5 * MiB, W_13 = 7 * MiB, W_2 = 23 * MiB;
constexpr size_t WS_WKV = 126 * MiB;
constexpr size_t WS_MEMN = 130 * MiB;
constexpr size_t WS_KVM = 131 * MiB;
constexpr size_t WS_HN = 133 * MiB;
constexpr size_t WS_CAT = 165 * MiB;
constexpr size_t WS_PROJ = 197 * MiB;
constexpr size_t WS_HID = 197 * MiB;
constexpr size_t WS_Y2 = 213 * MiB;
constexpr size_t WS_GW = 277 * MiB;
constexpr size_t WS_GP = 278 * MiB;
constexpr size_t WS_SUM = 279 * MiB;
constexpr size_t WS_EID = 281 * MiB;
constexpr size_t WS_EW = 282 * MiB;
constexpr size_t WS_LIST = 283 * MiB;
constexpr size_t WS_END = 284 * MiB;
constexpr int CW_AQ = 1024;
constexpr int CW_CNT = 2048;
constexpr int CW_BAR = 4096;

constexpr int RING_BYTES = 131072, LDSCTL_OFF = RING_BYTES, LDS_BYTES = 147456;

__device__ __forceinline__ unsigned cvt_pk_bf16(float lo, float hi) { unsigned r; asm volatile("v_cvt_pk_bf16_f32 %0, %1, %2" : "=v"(r) : "v"(lo), "v"(hi)); return r; }
__device__ __forceinline__ float bf2f(bf16 v) { return __uint_as_float(((unsigned)v) << 16); }
__device__ __forceinline__ float bflo(unsigned w) { return __uint_as_float(w << 16); }
__device__ __forceinline__ float bfhi(unsigned w) { return __uint_as_float(w & 0xffff0000u); }
__device__ __forceinline__ int lane_id() { int l = (int)__builtin_amdgcn_mbcnt_hi(~0u, __builtin_amdgcn_mbcnt_lo(~0u, 0u)); asm volatile("" : "+v"(l)); return l; }
__device__ __forceinline__ float wave_sum(float v) {
#pragma unroll
    for (int o = 1; o < 64; o <<= 1) v += __shfl_xor(v, o);
    return v;
}
__device__ __forceinline__ float wave_max(float v) {
#pragma unroll
    for (int o = 1; o < 64; o <<= 1) v = fmaxf(v, __shfl_xor(v, o));
    return v;
}
__device__ __forceinline__ float fast_sigmoid(float x) { return __builtin_amdgcn_rcpf(1.0f + __expf(-x)); }
__device__ __forceinline__ float gelu_tanh_fast(float x) {
    const float u = 0.7978845608028654f * (x + 0.044715f * x * x * x);
    return x * fast_sigmoid(2.0f * u);
}

__device__ const unsigned char BUCKET[128] = {
    0, 1, 2, 3, 4, 5, 6, 7, 8, 9, 10, 11, 12, 13, 14, 15, 16, 16, 16, 17, 17, 18, 18, 18, 19, 19, 19, 20, 20, 20, 20, 21, 21, 21, 21, 22, 22, 22, 22, 22,
    23, 23, 23, 23, 23, 23, 24, 24, 24, 24, 24, 24, 25, 25, 25, 25, 25, 25, 25, 26, 26, 26, 26, 26, 26, 26, 26, 27, 27, 27, 27, 27, 27, 27, 27, 27, 27,
    28, 28, 28, 28, 28, 28, 28, 28, 28, 28, 29, 29, 29, 29, 29, 29, 29, 29, 29, 29, 29, 29, 30, 30, 30, 30, 30, 30, 30, 30, 30, 30, 30, 30, 30, 30,
    31, 31, 31, 31, 31, 31, 31, 31, 31, 31, 31, 31, 31, 31, 31};

#define XB_TMO      128
#define XB_XCNT(j)  (256  + 64 * (j))
#define XB_XSUB(j)  (1280 + 64 * (j))
#define XB_XGEN(j)  (2304 + 64 * (j))
#define XB_TOP      3328
#define XB_TOPGEN   3392
#define XCD_BAR_WORDS 3456
#define XB_SPIN_CAP (1u << 22)

__device__ __forceinline__ unsigned xb_ld(unsigned* p)              { return __hip_atomic_load(p, __ATOMIC_RELAXED, __HIP_MEMORY_SCOPE_AGENT); }
__device__ __forceinline__ unsigned xb_add(unsigned* p, unsigned v) { return __hip_atomic_fetch_add(p, v, __ATOMIC_RELAXED, __HIP_MEMORY_SCOPE_AGENT); }
__device__ __forceinline__ unsigned xb_xcc_id() { return (unsigned)__builtin_amdgcn_s_getreg((3 << 11) | 20) & 0xFu; }
#define XB_SPIN(cond, bar) do { unsigned _sp = 0; while (cond) { __builtin_amdgcn_s_sleep(1); \
    if ((++_sp & 255u) == 0u) { if (xb_ld(&(bar)[XB_TMO])) break; if (_sp > XB_SPIN_CAP) { atomicAdd(&(bar)[XB_TMO], 1u); break; } } } } while (0)

struct XcdBarrier { unsigned* bar; unsigned x; volatile LAS unsigned* st; };

__device__ __forceinline__ XcdBarrier xcd_barrier_post(unsigned* bar, volatile LAS unsigned* st, bool leader) {
    XcdBarrier b; b.bar = bar; b.x = xb_xcc_id(); b.st = st;
    if (leader) (void)xb_add(&bar[XB_XCNT(b.x)], 1u);
    return b;
}
__device__ __forceinline__ void xcd_barrier_complete(unsigned* bar, unsigned x, unsigned& nloc, unsigned& nx) {
    const unsigned G = gridDim.x * gridDim.y * gridDim.z;
    unsigned sum, cnt, mine, sp = 0u;
    for (;;) {
        sum = 0u; cnt = 0u; mine = 0u;
#pragma unroll
        for (unsigned j = 0; j < 16; ++j) { const unsigned c = xb_ld(&bar[XB_XCNT(j)]); sum += c; cnt += (c > 0u) ? 1u : 0u; mine = (j == x) ? c : mine; }
        if (sum == G) break;
        __builtin_amdgcn_s_sleep(1);
        if ((++sp & 255u) == 0u) { if (xb_ld(&bar[XB_TMO])) break; if (sp > XB_SPIN_CAP) { atomicAdd(&bar[XB_TMO], 1u); break; } }
    }
    nloc = mine > 0u ? mine : 1u; nx = cnt > 0u ? cnt : 1u;
}
__device__ __forceinline__ void xcd_barrier(const XcdBarrier& b, bool leader) {
    asm volatile("s_waitcnt vmcnt(0)" ::: "memory");
    __syncthreads();
    if (leader) {
        unsigned* bar = b.bar;
        __builtin_amdgcn_s_waitcnt(0);
        unsigned nloc = b.st[0], nx = b.st[1];
        if (nloc == 0u) { xcd_barrier_complete(bar, b.x, nloc, nx); b.st[0] = nloc; b.st[1] = nx; }
        const unsigned old = xb_add(&bar[XB_XSUB(b.x)], 1u);
        const unsigned gen = old / nloc;
        if (old + 1u == (gen + 1u) * nloc) {
            __builtin_amdgcn_fence(__ATOMIC_RELEASE, "agent");
            asm volatile("s_waitcnt vmcnt(0)" ::: "memory");
            const unsigned og = xb_add(&bar[XB_TOP], 1u);
            const unsigned tg = og / nx;
            if (og + 1u == (tg + 1u) * nx) xb_add(&bar[XB_TOPGEN], 1u);
            else XB_SPIN(xb_ld(&bar[XB_TOPGEN]) == tg, bar);
            __builtin_amdgcn_fence(__ATOMIC_ACQUIRE, "agent");
            xb_add(&bar[XB_XGEN(b.x)], 1u);
            asm volatile("s_waitcnt vmcnt(0)" ::: "memory");
        } else {
            XB_SPIN(xb_ld(&bar[XB_XGEN(b.x)]) == gen, bar);
            __builtin_amdgcn_fence(__ATOMIC_ACQUIRE, "agent");
            asm volatile("s_waitcnt vmcnt(0)" ::: "memory");
        }
    }
    __syncthreads();
}

namespace pg8 {
constexpr int BM = 256, BK = 64, HALF = 128, HTB = HALF * BK * 2, STAGE_BYTES = 8 * HTB, NXCD = 8, WGM = 8;
__host__ __device__ __forceinline__ int lds_byte(int r, int c) { const int st = (r >> 4) * 2 + (c >> 5), rr = r & 15, cc = c & 31, ob = rr * 64 + cc * 2; return st * 1024 + (ob ^ (((ob >> 9) & 1) << 5)); }
__host__ __device__ __forceinline__ void stage_rc(int b, int& R, int& C) { const int st = b / 1024, sb = b % 1024, swz = sb ^ (((sb >> 9) & 1) << 5); R = (st >> 1) * 16 + swz / 64; C = (st & 1) * 32 + (swz % 64) / 2; }
__host__ __device__ __forceinline__ int perm32(int rho) { const int n = rho >> 4, i = rho & 15; return 8 * (i >> 2) + 4 * n + (i & 3); }

struct Unit { int pm, pn, e, cnt, par; };

struct DenseSched {
    static constexpr bool GATHER = false;
    const bf16* A; const bf16* Bt; int K, nM, nN, nwg, G, c;
    __device__ void init(const bf16* A_, const bf16* Bt_, int M, int N, int K_, int G_, int c_) { A = A_; Bt = Bt_; K = K_; nM = M / BM; nN = N / BM; nwg = nM * nN; G = G_; c = c_; }
    __device__ __forceinline__ bool next(int i, Unit& u) const {
        const long L = (long)i * G + c; if (L >= nwg) return false;
        int wgid = (int)L; { const int q = nwg / NXCD, r = nwg % NXCD, xcd = wgid % NXCD, off = wgid / NXCD; wgid = (xcd < r ? xcd * (q + 1) : r * (q + 1) + (xcd - r) * q) + off; }
        const int nig = WGM * nN, gid = wgid / nig, fm = gid * WGM, gsz = (nM - fm) < WGM ? (nM - fm) : WGM;
        u.pm = fm + ((wgid % nig) % gsz); u.pn = (wgid % nig) / gsz; u.e = 0; u.cnt = BM; u.par = 0; return true;
    }
    __device__ __forceinline__ const char* a_base(const Unit& u) const { return (const char*)A + (size_t)u.pm * BM * K * 2; }
    __device__ __forceinline__ const char* b_base(const Unit& u) const { return (const char*)Bt + (size_t)u.pn * BM * K * 2; }
};

template <class Epi, class Sched, bool ALIGN_EPI>
__device__ __forceinline__ void gemm_phase(LAS unsigned char* lds, const int wid, const int K, const Sched& S, const Epi& E) {
    const int lane = lane_id(), tid = wid * 64 + lane, wr = wid >> 2, wc = wid & 3, fr = lane & 15, fq = lane >> 4;
    const int nt = K / BK;
    int Rr[2], Cc[2]; unsigned voffB[2];
#pragma unroll
    for (int i = 0; i < 2; ++i) { int R, C; stage_rc(tid * 16 + i * 8192, R, C); Rr[i] = R; Cc[i] = C; const int Rb = Epi::PERM ? ((R & ~31) + perm32(R & 31)) : R;
        voffB[i] = (unsigned)(Rb * K + C) * 2u; }
    const size_t kstep = (size_t)(BK * 2);
    const size_t hstep = (size_t)HALF * K * 2;
    const unsigned ldsw = (unsigned)wid * 1024u;
    const int aoff = lds_byte(wr * 64 + fr, fq * 8), boff = lds_byte(wc * 32 + fr, fq * 8);
#define PG8_SA(b, h) (((b) * 2 + (h)) * HTB)
#define PG8_SB(b, h) ((4 + (b) * 2 + (h)) * HTB)
#define PG8_STAGE(bufoff, gbase, voff) do { _Pragma("unroll") for (int _i = 0; _i < 2; ++_i) \
        __builtin_amdgcn_global_load_lds((const unsigned*)((const char*)(gbase) + (voff)[_i]), (LAS unsigned*)(lds + (bufoff) + ldsw + _i * 8192), 16, 0, 0); } while (0)
#define PG8_LDA(dst, b, h) do { _Pragma("unroll") for (int m = 0; m < 4; ++m) _Pragma("unroll") for (int k = 0; k < 2; ++k) dst[m][k] = *(const LAS bf16x8*)(lds + PG8_SA(b, h) + aoff + m * 2048 + k * 1024); } while (0)
#define PG8_LDB(dst, b, h) do { _Pragma("unroll") for (int n = 0; n < 2; ++n) _Pragma("unroll") for (int k = 0; k < 2; ++k) dst[n][k] = *(const LAS bf16x8*)(lds + PG8_SB(b, h) + boff + n * 2048 + k * 1024); } while (0)
#define PG8_MMA(ai, bj, At, Bt) do { __builtin_amdgcn_s_setprio(1); _Pragma("unroll") for (int m = 0; m < 4; ++m) _Pragma("unroll") for (int n = 0; n < 2; ++n) _Pragma("unroll") for (int k = 0; k < 2; ++k) \
        acc[ai][bj][m][n] = __builtin_amdgcn_mfma_f32_16x16x32_bf16(Bt[n][k], At[m][k], acc[ai][bj][m][n], 0, 0, 0); __builtin_amdgcn_s_setprio(0); } while (0)
#define PG8_WAIT_V(n) asm volatile("s_waitcnt vmcnt(" #n ")" ::: "memory")
#define PG8_WAIT_L(n) asm volatile("s_waitcnt lgkmcnt(" #n ")" ::: "memory")
#define PG8_BAR __builtin_amdgcn_s_barrier()
#define PG8_SCHED __builtin_amdgcn_sched_barrier(0)
    Unit cur, nxt; int ui = 0;
    if (!S.next(0, cur)) return;
    cur.par = 0;
    f32x4 acc[2][2][4][2];
#pragma unroll
    for (int a = 0; a < 2; ++a)
#pragma unroll
        for (int b = 0; b < 2; ++b)
#pragma unroll
            for (int m = 0; m < 4; ++m)
#pragma unroll
                for (int n = 0; n < 2; ++n) acc[a][b][m][n] = (f32x4){0.f, 0.f, 0.f, 0.f};
    bf16x8 At[4][2], B0[2][2], B1[2][2];
    unsigned vAd[2][2];
#pragma unroll
    for (int h = 0; h < 2; ++h)
#pragma unroll
        for (int i = 0; i < 2; ++i) vAd[h][i] = (unsigned)((h * HALF + Rr[i]) * K + Cc[i]) * 2u;
    if constexpr (Sched::GATHER) { if (wid < 4) S.dma_slots(cur, 0, wid, tid); PG8_WAIT_V(0); __syncthreads(); }
#define PG8_STAGE_A(bufoff, gbase, par, h) do { if constexpr (Sched::GATHER) { unsigned _v[2]; _Pragma("unroll") for (int _i = 0; _i < 2; ++_i) _v[_i] = S.row_off(S.tabS[(par) * 256 + (h) * HALF + Rr[_i]]) + (unsigned)Cc[_i] * 2u; \
        PG8_WAIT_L(0); PG8_STAGE(bufoff, gbase, _v); } else { PG8_STAGE(bufoff, gbase, vAd[h]); } } while (0)
    const char* cA = S.a_base(cur); const char* cB = S.b_base(cur);
    PG8_STAGE(PG8_SB(0, 0), cB, voffB); PG8_STAGE(PG8_SB(0, 1), cB + hstep, voffB); PG8_STAGE_A(PG8_SA(0, 0), cA, 0, 0); PG8_STAGE_A(PG8_SA(0, 1), cA, 0, 1);
    if (wr == 1) PG8_BAR;
    PG8_WAIT_V(2); PG8_BAR;
    PG8_STAGE(PG8_SB(1, 0), cB + kstep, voffB); PG8_STAGE_A(PG8_SA(1, 0), cA + kstep, 0, 0); PG8_STAGE(PG8_SB(1, 1), cB + hstep + kstep, voffB);
    PG8_WAIT_V(6); PG8_BAR;
    for (;;) {
        const bool has_next = S.next(ui + 1, nxt);
        const int pc = ui & 1, pn_ = pc ^ 1;
        nxt.par = pn_;
        const char* nA = has_next ? S.a_base(nxt) : cA; const char* nB = has_next ? S.b_base(nxt) : cB;
#pragma nounroll
        for (int t = 0; t < nt; t += 2) {
            const bool last = (t == nt - 2);
            const char* a1 = cA + (size_t)(t + 1) * kstep;
            const char* a2 = last ? nA : cA + (size_t)(t + 2) * kstep; const char* b2 = last ? nB : cB + (size_t)(t + 2) * kstep;
            const char* a3 = a2 + kstep; const char* b3 = b2 + kstep;
            const int p2 = (last && has_next) ? pn_ : pc;
            PG8_LDB(B0, 0, 0); PG8_LDB(B1, 0, 1); PG8_SCHED; PG8_LDA(At, 0, 0); PG8_STAGE_A(PG8_SA(1, 1), a1, pc, 1);
            PG8_WAIT_V(8); PG8_WAIT_L(0); PG8_BAR; PG8_MMA(0, 0, At, B0); PG8_MMA(0, 1, At, B1); PG8_BAR; PG8_SCHED;
            PG8_LDA(At, 0, 1); PG8_STAGE(PG8_SB(0, 0), b2, voffB); PG8_STAGE(PG8_SB(0, 1), b2 + hstep, voffB); PG8_STAGE_A(PG8_SA(0, 0), a2, p2, 0);
            PG8_WAIT_V(8); PG8_WAIT_L(0); PG8_BAR; PG8_MMA(1, 0, At, B0); PG8_MMA(1, 1, At, B1); PG8_BAR; PG8_SCHED;
            if constexpr (Sched::GATHER) { if (t == 0 && has_next && wid < 4) S.dma_slots(nxt, pn_, wid, tid); }
            PG8_LDB(B0, 1, 0); PG8_LDB(B1, 1, 1); PG8_SCHED; PG8_LDA(At, 1, 0); PG8_STAGE_A(PG8_SA(0, 1), a2, p2, 1);
            PG8_WAIT_V(8); PG8_WAIT_L(0); PG8_BAR; PG8_MMA(0, 0, At, B0); PG8_MMA(0, 1, At, B1); PG8_BAR; PG8_SCHED;
            PG8_LDA(At, 1, 1); PG8_STAGE(PG8_SB(1, 0), b3, voffB); PG8_STAGE(PG8_SB(1, 1), b3 + hstep, voffB); PG8_STAGE_A(PG8_SA(1, 0), a3, p2, 0);
            PG8_WAIT_V(8); PG8_WAIT_L(0); PG8_BAR; PG8_MMA(1, 0, At, B0); PG8_MMA(1, 1, At, B1); PG8_BAR; PG8_SCHED;
        }
        if constexpr (ALIGN_EPI) { if (wr == 0) PG8_BAR; }
        E(acc, cur, wr, wc, fr, fq);
        if (!has_next) break;
#pragma unroll
        for (int a = 0; a < 2; ++a)
#pragma unroll
            for (int b = 0; b < 2; ++b)
#pragma unroll
                for (int m = 0; m < 4; ++m)
#pragma unroll
                    for (int n = 0; n < 2; ++n) acc[a][b][m][n] = (f32x4){0.f, 0.f, 0.f, 0.f};
        cur = nxt; cA = nA; cB = nB; ++ui;
        if constexpr (ALIGN_EPI) { if (wr == 1) PG8_BAR; }
    }
    PG8_WAIT_V(0);
    if constexpr (!ALIGN_EPI) { if (wr == 0) PG8_BAR; }
    PG8_BAR;
#undef PG8_SA
#undef PG8_SB
#undef PG8_STAGE
#undef PG8_STAGE_A
#undef PG8_LDA
#undef PG8_LDB
#undef PG8_MMA
#undef PG8_WAIT_V
#undef PG8_WAIT_L
#undef PG8_BAR
#undef PG8_SCHED
}

struct EpiStoreBf16 {
    static constexpr bool PERM = true;
    bf16* O; int ldc;
    __device__ __forceinline__ void operator()(const f32x4 (&acc)[2][2][4][2], const Unit& u, int wr, int wc, int fr, int fq) const {
        const int row0 = u.pm * BM + wr * 64 + fr, col0 = u.pn * BM + wc * 32 + 8 * fq;
#pragma unroll
        for (int ai = 0; ai < 2; ++ai)
#pragma unroll
            for (int m = 0; m < 4; ++m) { bf16* rowp = O + (size_t)(row0 + ai * HALF + m * 16) * ldc + col0;
#pragma unroll
                for (int bj = 0; bj < 2; ++bj) { const f32x4 v0 = acc[ai][bj][m][0], v1 = acc[ai][bj][m][1];
                    u32x4 w; w.x = cvt_pk_bf16(v0[0], v0[1]); w.y = cvt_pk_bf16(v0[2], v0[3]); w.z = cvt_pk_bf16(v1[0], v1[1]); w.w = cvt_pk_bf16(v1[2], v1[3]);
                    *(u32x4*)(rowp + bj * HALF) = w; } }
    }
};
struct EpiResF32 {
    static constexpr bool PERM = false;
    const float* base; float* out; int ldc;
    __device__ __forceinline__ void operator()(const f32x4 (&acc)[2][2][4][2], const Unit& u, int wr, int wc, int fr, int fq) const {
        const int col0 = u.pn * BM + wc * 32 + 4 * fq;
#pragma unroll
        for (int ai = 0; ai < 2; ++ai)
#pragma unroll
            for (int m = 0; m < 4; ++m) { const size_t off = (size_t)(u.pm * BM + ai * HALF + wr * 64 + m * 16 + fr) * ldc + col0;
#pragma unroll
                for (int bj = 0; bj < 2; ++bj)
#pragma unroll
                    for (int n = 0; n < 2; ++n) { const f32x4 bs = *(const f32x4*)(base + off + bj * HALF + n * 16); *(f32x4*)(out + off + bj * HALF + n * 16) = bs + acc[ai][bj][m][n]; }
                if (m & 1) asm volatile("" ::: "memory"); }
    }
};
struct MoeSched {
    static constexpr bool GATHER = true;
    const bf16* A; const bf16* Bt; int K; size_t bt_estride; int npn, shift; const int* list; const LAS int* tab  ;
    LAS int* tabS  ; int G, c;
    __device__ __forceinline__ bool next(int i, Unit& u) const {
        const int L = i * G + c, nu = __builtin_amdgcn_readfirstlane(tab[32]) * npn; if (L >= nu) return false;
        const int ti = L / npn; u.pn = L % npn; int e = 0;
#pragma unroll
        for (int k = 1; k < 16; ++k) if (ti >= __builtin_amdgcn_readfirstlane(tab[16 + k])) e = k;
        u.e = e; u.pm = ti - __builtin_amdgcn_readfirstlane(tab[16 + e]); const int rem = __builtin_amdgcn_readfirstlane(tab[e]) - BM * u.pm; u.cnt = rem < BM ? rem : BM; u.par = 0; return true;
    }
    __device__ __forceinline__ const char* a_base(const Unit&) const { return (const char*)A; }
    __device__ __forceinline__ const char* b_base(const Unit& u) const { return (const char*)Bt + (size_t)u.e * bt_estride + (size_t)u.pn * BM * K * 2; }
    __device__ __forceinline__ void dma_slots(const Unit& u, int par, int wid, int tid) const {
        const int rr = tid < u.cnt ? tid : u.cnt - 1;
        __builtin_amdgcn_global_load_lds((const unsigned*)(list + (size_t)u.e * T + BM * u.pm + rr), (LAS unsigned*)(tabS + par * 256 + wid * 64), 4, 0, 0); }
    __device__ __forceinline__ unsigned row_off(int slot) const { return (unsigned)(slot >> shift) * (unsigned)(K * 2); }
};
struct EpiMoe1 {
    static constexpr bool PERM = true;
    bf16* hid; const LAS int* tabS; const float* ew;
    __device__ __forceinline__ void operator()(const f32x4 (&acc)[2][2][4][2], const Unit& u, int wr, int wc, int fr, int fq) const {
#pragma unroll
        for (int ai = 0; ai < 2; ++ai)
#pragma unroll
            for (int m = 0; m < 4; ++m) { const int r = ai * HALF + wr * 64 + m * 16 + fr;
                const int slot = tabS[u.par * 256 + r];
                if (r < u.cnt) { const float w = ew[slot];
                    float hv[8];
#pragma unroll
                    for (int n = 0; n < 2; ++n)
#pragma unroll
                        for (int k = 0; k < 4; ++k) { const float a = acc[ai][0][m][n][k], uu = acc[ai][1][m][n][k]; hv[4 * n + k] = a * __builtin_amdgcn_rcpf(1.0f + __expf(-a)) * uu * w; }
                    u32x4 o; o.x = cvt_pk_bf16(hv[0], hv[1]); o.y = cvt_pk_bf16(hv[2], hv[3]); o.z = cvt_pk_bf16(hv[4], hv[5]); o.w = cvt_pk_bf16(hv[6], hv[7]);
                    *(u32x4*)(hid + (size_t)slot * DE + u.pn * HALF + wc * 32 + 8 * fq) = o; } }
    }
};
struct EpiMoe2 {
    static constexpr bool PERM = true;
    bf16* y2; const LAS int* tabS;
    __device__ __forceinline__ void operator()(const f32x4 (&acc)[2][2][4][2], const Unit& u, int wr, int wc, int fr, int fq) const {
#pragma unroll
        for (int ai = 0; ai < 2; ++ai)
#pragma unroll
            for (int m = 0; m < 4; ++m) { const int r = ai * HALF + wr * 64 + m * 16 + fr;
                const int slot = tabS[u.par * 256 + r];
                if (r < u.cnt) {
                    bf16* rowp = y2 + (size_t)slot * D + u.pn * BM + wc * 32 + 8 * fq;
#pragma unroll
                    for (int bj = 0; bj < 2; ++bj) { const f32x4 v0 = acc[ai][bj][m][0], v1 = acc[ai][bj][m][1];
                        u32x4 o; o.x = cvt_pk_bf16(v0[0], v0[1]); o.y = cvt_pk_bf16(v0[2], v0[3]); o.z = cvt_pk_bf16(v1[0], v1[1]); o.w = cvt_pk_bf16(v1[2], v1[3]);
                        *(u32x4*)(rowp + bj * HALF) = o; } } }
    }
};
}

struct Args { const float* in[28]; float* out; unsigned char* ws; int ph_mask, seam_mask, l_lo, l_hi, li, pad; };
enum { I_X = 0, I_MEM, I_NMG, I_WINA, I_WINB, I_WOUT, I_CW, I_CB, I_GAW, I_GAB, I_GXW, I_GXB, I_LAM, I_LQ1, I_LK1, I_LQ2, I_LK2, I_SUBG, I_RELB, I_MNG, I_WKV, I_NFG, I_WG, I_WR, I_W1, I_W3, I_W2, I_FNG };
enum { K_PRO = 0, K_KVM, K_N1, K_G1, K_M1, K_M2, K_G2, K_N2, K_E1, K_E2, K_FIN, K_NUM };

__device__ __forceinline__ void transpose_item(const float* W, int ldw, int k0, int nsrc0, bf16* WT, int ldt, int drow0, float scale, LAS float* scr, int lane) {
#pragma unroll 8
    for (int i = 0; i < 32; ++i) { const int kk = 2 * i + (lane >> 5); scr[kk * 33 + (lane & 31)] = W[(size_t)(k0 + kk) * ldw + nsrc0 + (lane & 31)] * scale; }
    asm volatile("s_waitcnt lgkmcnt(0)" ::: "memory");
    const int c = lane & 7;
#pragma unroll
    for (int j = 0; j < 4; ++j) { const int n = (lane >> 3) + 8 * j; const LAS float* s = scr + (8 * c) * 33 + n;
        u32x4 o; o.x = cvt_pk_bf16(s[0 * 33], s[1 * 33]); o.y = cvt_pk_bf16(s[2 * 33], s[3 * 33]); o.z = cvt_pk_bf16(s[4 * 33], s[5 * 33]); o.w = cvt_pk_bf16(s[6 * 33], s[7 * 33]);
        *(u32x4*)(WT + (size_t)(drow0 + n) * ldt + k0 + 8 * c) = o; }
    asm volatile("s_waitcnt lgkmcnt(0)" ::: "memory");
}
__device__ __forceinline__ void norm_row(const float* xrow, const bf16* y0, const bf16* y1, float* hrow_out, const float* g, bf16* orow, float* frow, int lane) {
    asm volatile("" : "+v"(lane));
    f32x4 v[4]; float ss = 0.f;
#pragma unroll
    for (int j = 0; j < 4; ++j) {
        v[j] = ((const f32x4*)xrow)[64 * j + lane];
        if (y0) { const u32x2 a = ((const u32x2*)y0)[64 * j + lane], b = ((const u32x2*)y1)[64 * j + lane];
            v[j][0] += bflo(a.x) + bflo(b.x); v[j][1] += bfhi(a.x) + bfhi(b.x); v[j][2] += bflo(a.y) + bflo(b.y); v[j][3] += bfhi(a.y) + bfhi(b.y); }
        ss += (v[j][0] * v[j][0] + v[j][1] * v[j][1]) + (v[j][2] * v[j][2] + v[j][3] * v[j][3]);
    }
    if (hrow_out) {
#pragma unroll
        for (int j = 0; j < 4; ++j) ((f32x4*)hrow_out)[64 * j + lane] = v[j];
    }
    const float r = rsqrtf(wave_sum(ss) * (1.0f / D) + EPS);
#pragma unroll
    for (int j = 0; j < 4; ++j) {
        const f32x4 gg = ((const f32x4*)g)[64 * j + lane];
        const f32x4 o = v[j] * r * gg;
        if (orow) { u32x2 w; w.x = cvt_pk_bf16(o[0], o[1]); w.y = cvt_pk_bf16(o[2], o[3]); ((u32x2*)orow)[64 * j + lane] = w; }
        if (frow) ((f32x4*)frow)[64 * j + lane] = o;
    }
}

constexpr int RG_L = 128, RG_NCH = S / RG_L;
constexpr int RG_XF = 0, RG_AF = 51200, RG_XB = 102400;
template <int PASS>
__device__ __forceinline__ void rglru_unit(LAS unsigned char* lds, const int wid, int b, int c, int g, const bf16* proj, const float* cw, const float* cb, const bf16* gw  ,
                                           const float* gp  , float* sumA, float* sumB, bf16* cat) {
    const int lane = lane_id(), tid = wid * 64 + lane;
    LAS float* XF = (LAS float*)(lds + RG_XF); LAS float* AF = (LAS float*)(lds + RG_AF); LAS bf16* XB = (LAS bf16*)(lds + RG_XB);
    float hc = 0.f;
    if (PASS == 2 && tid < 96) {
        const float* pa = sumA + (size_t)b * RG_NCH * TW + g * 96 + tid; const float* pb = sumB + (size_t)b * RG_NCH * TW + g * 96 + tid;
        int cc = 0;
        for (; cc + 8 <= c; cc += 8) { float av[8], bv[8];
#pragma unroll
            for (int k = 0; k < 8; ++k) { av[k] = pa[(size_t)(cc + k) * TW]; bv[k] = pb[(size_t)(cc + k) * TW]; }
#pragma unroll
            for (int k = 0; k < 8; ++k) hc = av[k] * hc + bv[k]; }
        for (; cc < c; ++cc) hc = pa[(size_t)cc * TW] * hc + pb[(size_t)cc * TW];
    }
    const int tk = tid >> 2, cq = tid & 3, ch0 = cq * 24;
    const int s = c * RG_L + tk; const size_t t = (size_t)b * S + s;
    {
        float acc[24];
#pragma unroll
        for (int k = 0; k < 24; k += 4) { const f32x4 v = *(const f32x4*)(cb + g * 96 + ch0 + k); acc[k] = v[0]; acc[k + 1] = v[1]; acc[k + 2] = v[2]; acc[k + 3] = v[3]; }
#pragma unroll
        for (int w = 0; w < 4; ++w) {
            if (s + w - 3 >= 0) {
                const bf16* xr = proj + (t + w - 3) * PLD + g * 96 + ch0;
#pragma unroll
                for (int q = 0; q < 3; ++q) {
                    const u32x4 xv = *(const u32x4*)(xr + 8 * q);
                    const f32x4 w0 = *(const f32x4*)(cw + w * TW + g * 96 + ch0 + 8 * q), w1 = *(const f32x4*)(cw + w * TW + g * 96 + ch0 + 8 * q + 4);
                    acc[8 * q + 0] += w0[0] * bflo(xv.x); acc[8 * q + 1] += w0[1] * bfhi(xv.x); acc[8 * q + 2] += w0[2] * bflo(xv.y); acc[8 * q + 3] += w0[3] * bfhi(xv.y);
                    acc[8 * q + 4] += w1[0] * bflo(xv.z); acc[8 * q + 5] += w1[1] * bfhi(xv.z); acc[8 * q + 6] += w1[2] * bflo(xv.w); acc[8 * q + 7] += w1[3] * bfhi(xv.w);
                }
            }
        }
#pragma unroll
        for (int k = 0; k < 24; k += 4) *(LAS f32x4*)(XF + tk * 100 + ch0 + k) = (f32x4){acc[k], acc[k + 1], acc[k + 2], acc[k + 3]};
#pragma unroll
        for (int q = 0; q < 3; ++q) { u32x4 w; w.x = cvt_pk_bf16(acc[8 * q], acc[8 * q + 1]); w.y = cvt_pk_bf16(acc[8 * q + 2], acc[8 * q + 3]); w.z = cvt_pk_bf16(acc[8 * q + 4], acc[8 * q + 5]); w.w = cvt_pk_bf16(acc[8 * q + 6], acc[8 * q + 7]);
            *(LAS u32x4*)(XB + tk * 104 + ch0 + 8 * q) = w; }
    }
    __syncthreads();
    {
        const int fr = lane & 15, fq = lane >> 4;
        bf16x8 af[3];
#pragma unroll
        for (int ks = 0; ks < 3; ++ks) af[ks] = *(const LAS bf16x8*)(XB + (16 * wid + fr) * 104 + ks * 32 + 8 * fq);
#pragma unroll
        for (int nt = 0; nt < 6; ++nt) {
            f32x4 dr = (f32x4){0.f, 0.f, 0.f, 0.f}, di = dr;
#pragma unroll
            for (int ks = 0; ks < 3; ++ks) {
                const bf16x8 br = *(const bf16x8*)(gw + ((size_t)(0 * 8 + g) * 96 + nt * 16 + fr) * 96 + ks * 32 + 8 * fq);
                const bf16x8 bi = *(const bf16x8*)(gw + ((size_t)(1 * 8 + g) * 96 + nt * 16 + fr) * 96 + ks * 32 + 8 * fq);
                dr = __builtin_amdgcn_mfma_f32_16x16x32_bf16(af[ks], br, dr, 0, 0, 0);
                di = __builtin_amdgcn_mfma_f32_16x16x32_bf16(af[ks], bi, di, 0, 0, 0);
            }
            const int ch = nt * 16 + fr, chg = g * 96 + ch;
            const float ba = gp[chg], bx = gp[TW + chg], c8 = gp[2 * TW + chg];
#pragma unroll
            for (int i = 0; i < 4; ++i) {
                const int tkk = 16 * wid + 4 * fq + i;
                const float r = fast_sigmoid(dr[i] + ba), ig = fast_sigmoid(di[i] + bx);
                const float la = c8 * r;
                const float a = __expf(la);
                const float x2 = 2.0f * la;
                float p = 1.0f + x2 * (1.0f / 7.0f); p = 1.0f + x2 * (1.0f / 6.0f) * p; p = 1.0f + x2 * (1.0f / 5.0f) * p; p = 1.0f + x2 * 0.25f * p; p = 1.0f + x2 * (1.0f / 3.0f) * p; p = 1.0f + x2 * 0.5f * p;
                float om = -x2 * p;
                if (x2 < -0.25f) om = 1.0f - a * a;
                const float bc = sqrtf(om);
                const float xv = XF[tkk * 100 + ch];
                AF[tkk * 100 + ch] = a;
                XF[tkk * 100 + ch] = bc * (ig * xv);
            }
        }
    }
    __syncthreads();
    if (tid < 96) {
        float h = hc, ap = 1.f;
        for (int k0 = 0; k0 < RG_L; k0 += 16) {
            float av[16], bv[16];
#pragma unroll
            for (int k = 0; k < 16; ++k) { av[k] = AF[(k0 + k) * 100 + tid]; bv[k] = XF[(k0 + k) * 100 + tid]; }
#pragma unroll
            for (int k = 0; k < 16; ++k) { h = av[k] * h + bv[k]; if (PASS == 1) ap *= av[k]; else XF[(k0 + k) * 100 + tid] = h; }
        }
        if (PASS == 1) { sumA[((size_t)b * RG_NCH + c) * TW + g * 96 + tid] = ap; sumB[((size_t)b * RG_NCH + c) * TW + g * 96 + tid] = h; }
    }
    if (PASS == 2) {
        __syncthreads();
        const bf16* ugr = proj + t * PLD + TW + g * 96 + ch0;
        bf16* orow = cat + t * D + g * 96 + ch0;
#pragma unroll
        for (int q = 0; q < 3; ++q) {
            const u32x4 uv = *(const u32x4*)(ugr + 8 * q);
            const f32x4 h0 = *(const LAS f32x4*)(XF + tk * 100 + ch0 + 8 * q), h1 = *(const LAS f32x4*)(XF + tk * 100 + ch0 + 8 * q + 4);
            u32x4 w;
            w.x = cvt_pk_bf16(h0[0] * gelu_tanh_fast(bflo(uv.x)), h0[1] * gelu_tanh_fast(bfhi(uv.x)));
            w.y = cvt_pk_bf16(h0[2] * gelu_tanh_fast(bflo(uv.y)), h0[3] * gelu_tanh_fast(bfhi(uv.y)));
            w.z = cvt_pk_bf16(h1[0] * gelu_tanh_fast(bflo(uv.z)), h1[1] * gelu_tanh_fast(bfhi(uv.z)));
            w.w = cvt_pk_bf16(h1[2] * gelu_tanh_fast(bflo(uv.w)), h1[3] * gelu_tanh_fast(bfhi(uv.w)));
            *(u32x4*)(orow + 8 * q) = w;
        }
    }
    __syncthreads();
}

namespace att {
typedef float f32x16 __attribute__((ext_vector_type(16)));
typedef short s16x4 __attribute__((ext_vector_type(4)));
constexpr int SLOT = 32768, NSLOT = 3, L_K = 0, L_V = 16384;
constexpr int L_WSF = NSLOT * SLOT, L_TB = L_WSF + 8 * 256, L_END = L_TB + 512;
constexpr int L_X = 0, L_OST = 65536;
constexpr float THR = 8.0f, LOG2E = 1.4426950408889634f;
static_assert(L_END <= RING_BYTES && L_OST + 32768 <= L_WSF, "attention LDS map");
__device__ __forceinline__ int crow(int r, int hi) { return (r & 3) + 8 * (r >> 2) + 4 * hi; }
#define ATT_WAIT_BAR(N) asm volatile("s_waitcnt vmcnt(" #N ") lgkmcnt(0)\n\ts_barrier" ::: "memory")
#define ATT_MFMA(a, b, c) __builtin_amdgcn_mfma_f32_32x32x16_bf16(a, b, c, 0, 0, 0)

template <int MODE>
__device__ __forceinline__ void attn_unit(LAS unsigned char* lds, const int wid, const int b, const int hh, const int qb,
                                          const bf16* proj, const bf16* kvm, const int layer, const int qoff, const float* rel_bias, const float* subg, const float lam, const float lambda_init, bf16* cat) {
    const int lane = lane_id(), r32 = lane & 31, hi = lane >> 5, mp = wid >> 2, wq = wid & 3, tid = wid * 64 + lane;
    const int q0 = qb * 128, qw0 = q0 + 32 * wq, qrow = qw0 + r32;
    const int NT = (MODE == 0) ? (q0 + 128) / 64 : 4;
    constexpr int NDB = (MODE == 0) ? 4 : 2;
    const bf16* Qp; const bf16* Kg0; const bf16* Kg1; const bf16* Vg0; const bf16* Vg1; int ldk;
    if (MODE == 0) { const bf16* pb_ = proj + (size_t)b * S * PLD; Qp = pb_ + (size_t)qrow * PLD + hh * 128 + mp * 64; Kg0 = pb_ + 768 + hh * 128; Kg1 = Kg0 + 64; Vg0 = pb_ + 1536 + hh * 128; Vg1 = Vg0; ldk = PLD; }
    else { const bf16* kb_ = kvm + (size_t)b * ML * 2048 + layer * 512; Qp = proj + ((size_t)b * S + qrow) * PLD + qoff + (hh * 2 + mp) * 64; Kg0 = kb_ + (hh * 2) * 64; Kg1 = Kg0 + 64; Vg0 = Kg0 + 256; Vg1 = Kg1 + 256; ldk = 2048; }
    const bf16* ks0 = Kg0 + (size_t)lane * ldk + wid * 8; const bf16* ks1 = Kg1 + (size_t)lane * ldk + wid * 8;
    const bf16* vs[2];
#pragma unroll
    for (int i = 0; i < 2; ++i) { const int pc = wid * 2 + i, rg = pc & 3;
        if (MODE == 0) vs[i] = Vg0 + (size_t)(16 * rg + (lane >> 2)) * ldk + (pc >> 2) * 32 + (lane & 3) * 8;
        else vs[i] = ((pc >> 3) ? Vg1 : Vg0) + (size_t)(16 * rg + (lane >> 2)) * ldk + ((pc >> 2) & 1) * 32 + (lane & 3) * 8; }
    const size_t tstep = (size_t)64 * ldk;
#define ATT_DMA(t, slot) do { LAS unsigned char* sb_ = lds + (slot) * SLOT; \
        __builtin_amdgcn_global_load_lds((const unsigned*)(ks0 + (size_t)(t) * tstep), (LAS unsigned*)(sb_ + L_K + wid * 1024), 16, 0, 0); \
        __builtin_amdgcn_global_load_lds((const unsigned*)(ks1 + (size_t)(t) * tstep), (LAS unsigned*)(sb_ + L_K + 8192 + wid * 1024), 16, 0, 0); \
        __builtin_amdgcn_global_load_lds((const unsigned*)(vs[0] + (size_t)(t) * tstep), (LAS unsigned*)(sb_ + L_V + wid * 2048), 16, 0, 0); \
        __builtin_amdgcn_global_load_lds((const unsigned*)(vs[1] + (size_t)(t) * tstep), (LAS unsigned*)(sb_ + L_V + wid * 2048 + 1024), 16, 0, 0); } while (0)
    ATT_DMA(0, 0);
    if (NT > 1) ATT_DMA(1, 1);
    LAS float* tb = (LAS float*)(lds + L_TB); LAS float* wsf = (LAS float*)(lds + L_WSF) + wid * 64;
    if (MODE == 0 && tid < 128) tb[tid] = (rel_bias[(int)BUCKET[tid] * 6 + hh] - rel_bias[31 * 6 + hh]) * LOG2E;
    bf16x8 qr[4];
#pragma unroll
    for (int d0 = 0; d0 < 4; ++d0) qr[d0] = *(const bf16x8*)(Qp + d0 * 16 + hi * 8);
    f32x16 o[NDB];
#pragma unroll
    for (int d0 = 0; d0 < NDB; ++d0) o[d0] = (f32x16){0.f, 0.f, 0.f, 0.f, 0.f, 0.f, 0.f, 0.f, 0.f, 0.f, 0.f, 0.f, 0.f, 0.f, 0.f, 0.f};
    float mref = -INFINITY, lsum = 0.f;
    f32x16 negm;
#pragma unroll
    for (int r = 0; r < 16; ++r) negm[r] = 0.f;
    const int koff = hi * 1024 + r32 * 16 + mp * 8192;
    const int voff = L_V + ((MODE == 1) ? mp * 8192 : 0) + ((lane >> 4) & 1) * 32 + (lane & 3) * 8 + (4 * hi + ((lane & 15) >> 2)) * 64;
    int slot = 0;
    for (int t = 0; t < NT; ++t) {
        if (t + 1 < NT) ATT_WAIT_BAR(4); else ATT_WAIT_BAR(0);
        if (t + 2 < NT) { const int s2 = (slot + 2 >= NSLOT) ? slot + 2 - NSLOT : slot + 2; ATT_DMA(t + 2, s2); }
        const LAS unsigned char* sb = lds + slot * SLOT;
        f32x16 p0, p1;
        {
            const LAS unsigned char* kp = sb + L_K + koff;
#pragma unroll
            for (int d0 = 0; d0 < 4; ++d0) {
                const bf16x8 k0 = *(const LAS bf16x8*)(kp + d0 * 2048), k1 = *(const LAS bf16x8*)(kp + d0 * 2048 + 512);
                p0 = ATT_MFMA(k0, qr[d0], d0 == 0 ? negm : p0); p1 = ATT_MFMA(k1, qr[d0], d0 == 0 ? negm : p1);
            }
        }
        if (MODE == 0) {
            if (64 * t + 63 + 112 >= qw0) {
                const int nb = qrow - 64 * t - 4 * hi;
#pragma unroll
                for (int r = 0; r < 16; ++r) { const int n0 = nb - ((r & 3) + 8 * (r >> 2)), n1 = n0 - 32;
                    const float b0 = tb[n0 < 0 ? 0 : (n0 > 127 ? 127 : n0)], b1 = tb[n1 < 0 ? 0 : (n1 > 127 ? 127 : n1)];
                    p0[r] = n0 < 0 ? -INFINITY : p0[r] + b0; p1[r] = n1 < 0 ? -INFINITY : p1[r] + b1; }
            }
        }
        float rm = fmaxf(p0[0], p1[0]);
#pragma unroll
        for (int r = 1; r < 16; ++r) rm = fmaxf(rm, fmaxf(p0[r], p1[r]));
        { auto rr = __builtin_amdgcn_permlane32_swap(__float_as_uint(rm), __float_as_uint(rm), false, false); rm = fmaxf(__uint_as_float(rr[0]), __uint_as_float(rr[1])); }
        const bool grow = (mref == -INFINITY) ? true : (rm > THR);
        if (__any(grow)) {
            const float dl = (mref == -INFINITY) ? rm : fmaxf(rm, 0.f);
            const float alpha = (mref == -INFINITY) ? 0.f : __builtin_amdgcn_exp2f(-dl);
            mref = (mref == -INFINITY) ? rm : mref + dl;
#pragma unroll
            for (int r = 0; r < 16; ++r) { p0[r] -= dl; p1[r] -= dl; negm[r] = -mref; }
            lsum *= alpha;
            if (hi == 0) wsf[r32] = alpha;
            asm volatile("s_waitcnt lgkmcnt(0)" ::: "memory");
#pragma unroll
            for (int r = 0; r < 16; ++r) { const float a = wsf[crow(r, hi)];
#pragma unroll
                for (int d0 = 0; d0 < NDB; ++d0) o[d0][r] *= a; }
        }
        float sacc = 0.f;
#pragma unroll
        for (int r = 0; r < 16; ++r) { p0[r] = __builtin_amdgcn_exp2f(p0[r]); p1[r] = __builtin_amdgcn_exp2f(p1[r]); sacc += p0[r] + p1[r]; }
        lsum += sacc;
        u32x4 pw[4];
#pragma unroll
        for (int k = 0; k < 4; ++k) { pw[0][k] = cvt_pk_bf16(p0[2 * k], p0[2 * k + 1]); pw[1][k] = cvt_pk_bf16(p0[8 + 2 * k], p0[9 + 2 * k]); pw[2][k] = cvt_pk_bf16(p1[2 * k], p1[2 * k + 1]); pw[3][k] = cvt_pk_bf16(p1[8 + 2 * k], p1[9 + 2 * k]); }
        {
            const LAS unsigned char* vp = sb + voff;
#pragma unroll
            for (int d0 = 0; d0 < NDB; ++d0)
#pragma unroll
                for (int ks = 0; ks < 4; ++ks) {
                    const s16x4 lo = __builtin_bit_cast(s16x4, __builtin_amdgcn_ds_read_tr16_b64_v4i16((LAS s16x4*)(vp + d0 * 4096 + ks * 1024)));
                    const s16x4 hv = __builtin_bit_cast(s16x4, __builtin_amdgcn_ds_read_tr16_b64_v4i16((LAS s16x4*)(vp + d0 * 4096 + ks * 1024 + 512)));
                    const bf16x8 vf = (bf16x8){lo[0], lo[1], lo[2], lo[3], hv[0], hv[1], hv[2], hv[3]};
                    o[d0] = ATT_MFMA(__builtin_bit_cast(bf16x8, pw[ks]), vf, o[d0]);
                }
        }
        slot = (slot + 1 >= NSLOT) ? 0 : slot + 1;
    }
    { auto rr = __builtin_amdgcn_permlane32_swap(__float_as_uint(lsum), __float_as_uint(lsum), false, false); lsum = __uint_as_float(rr[0]) + __uint_as_float(rr[1]); }
    if (hi == 0) wsf[32 + r32] = 1.0f / lsum;
    asm volatile("s_waitcnt lgkmcnt(0)" ::: "memory");
#pragma unroll
    for (int r = 0; r < 16; ++r) { const float a = wsf[32 + crow(r, hi)];
#pragma unroll
        for (int d0 = 0; d0 < NDB; ++d0) o[d0][r] *= a; }
    ATT_WAIT_BAR(0);
    if (MODE == 0) {
        LAS float* X = (LAS float*)(lds + L_X);
        if (mp == 1) {
#pragma unroll
            for (int d0 = 0; d0 < 4; ++d0)
#pragma unroll
                for (int r = 0; r < 16; ++r) X[((wq * 4 + d0) * 16 + r) * 64 + lane] = o[d0][r];
        }
        ATT_WAIT_BAR(0);
        if (mp == 0) {
            float ss[16];
#pragma unroll
            for (int r = 0; r < 16; ++r) { float a = 0.f;
#pragma unroll
                for (int d0 = 0; d0 < 4; ++d0) { const float v = o[d0][r] - lam * X[((wq * 4 + d0) * 16 + r) * 64 + lane]; o[d0][r] = v; a += v * v; }
                ss[r] = a; }
#pragma unroll
            for (int off = 1; off < 32; off <<= 1)
#pragma unroll
                for (int r = 0; r < 16; ++r) ss[r] += __shfl_xor(ss[r], off);
            float gd[4];
#pragma unroll
            for (int d0 = 0; d0 < 4; ++d0) gd[d0] = subg[d0 * 32 + r32] * (1.0f - lambda_init);
            LAS bf16* ost = (LAS bf16*)(lds + L_OST) + wq * 4096;
#pragma unroll
            for (int r = 0; r < 16; ++r) { const float rn = rsqrtf(ss[r] * (1.0f / 128.0f) + EPS); const int row = crow(r, hi);
#pragma unroll
                for (int d0 = 0; d0 < 4; ++d0) ost[row * 128 + d0 * 32 + r32] = (bf16)(cvt_pk_bf16(o[d0][r] * rn * gd[d0], 0.f) & 0xffffu); }
            asm volatile("s_waitcnt lgkmcnt(0)" ::: "memory");
            bf16* op = cat + ((size_t)b * S + qw0) * D + hh * 128;
#pragma unroll
            for (int i = 0; i < 8; ++i) { const int c = i * 64 + lane, row = c >> 4, ch = c & 15; *(u32x4*)(op + (size_t)row * D + ch * 8) = *(const LAS u32x4*)(ost + row * 128 + ch * 8); }
        }
    } else {
        LAS bf16* ost = (LAS bf16*)(lds + L_OST) + wid * 2048;
#pragma unroll
        for (int r = 0; r < 16; ++r) { const int row = crow(r, hi);
#pragma unroll
            for (int d0 = 0; d0 < 2; ++d0) ost[row * 64 + d0 * 32 + r32] = (bf16)(cvt_pk_bf16(o[d0][r], 0.f) & 0xffffu); }
        asm volatile("s_waitcnt lgkmcnt(0)" ::: "memory");
        bf16* op = cat + ((size_t)b * S + qw0) * D + TW + (hh * 2 + mp) * 64;
#pragma unroll
        for (int i = 0; i < 4; ++i) { const int c = i * 64 + lane, row = c >> 3, ch = c & 7; *(u32x4*)(op + (size_t)row * D + ch * 8) = *(const LAS u32x4*)(ost + row * 64 + ch * 8); }
    }
    ATT_WAIT_BAR(0);
#undef ATT_DMA
}
__device__ __forceinline__ void attn_phase(LAS unsigned char* lds, const int wave, const bool diff, unsigned* qctr, volatile LAS unsigned* qword,
                                           const bf16* proj, const bf16* kvm, const int layer, const int qoff, const float* rel_bias, const float* lq1, const float* lk1, const float* lq2, const float* lk2,
                                           const float* subg, const float lambda_init, bf16* cat) {
    float lam = 0.f;
    if (diff) { const int l = lane_id(); lam = __expf(wave_sum(lq1[l] * lk1[l])) - __expf(wave_sum(lq2[l] * lk2[l])) + lambda_init; }
    const int ndiff = diff ? NB * 6 * (S / 128) : 0, ntot = ndiff + NB * 2 * (S / 128);
    for (;;) {
        if (wave == 0 && lane_id() == 0) qword[0] = __hip_atomic_fetch_add(qctr, 1u, __ATOMIC_RELAXED, __HIP_MEMORY_SCOPE_AGENT);
        __syncthreads();
        const int u = __builtin_amdgcn_readfirstlane((int)qword[0]);
        if (u >= ntot) break;
        if (u < ndiff) { const int bh = u % 12; attn_unit<0>(lds, wave, bh / 6, bh % 6, 63 - u / 12, proj, kvm, layer, qoff, rel_bias, subg, lam, lambda_init, cat); }
        else { const int v = u - ndiff; attn_unit<1>(lds, wave, v >> 7, (v >> 6) & 1, v & 63, proj, kvm, layer, qoff, rel_bias, subg, lam, lambda_init, cat); }
    }
    __syncthreads();
}
#undef ATT_WAIT_BAR
#undef ATT_MFMA
}

constexpr int GT_TABA = LDSCTL_OFF + 4096, GT_TABS = LDSCTL_OFF + 6144;
constexpr int RT_TAB = LDSCTL_OFF + 1024;
__device__ __forceinline__ void route_phase(LAS unsigned char* lds, const int wave, const float* h, const float* g, const float* wg, const float* wr, bf16* hn, unsigned* gcnt, int* list, float* ew, int G, int bx) {
    const int lane = lane_id(), tid = wave * 64 + lane;
    LAS float* WL = (LAS float*)lds;
    LAS int* lcnt = (LAS int*)(lds + RT_TAB); LAS int* lbase = lcnt + 16; LAS int* rinfo = lcnt + 32; LAS float* rw = (LAS float*)(lcnt + 32 + 256);
    for (int idx = tid; idx < 20 * D; idx += NTHR) { const int o = idx >> 10, d = idx & 1023; WL[idx] = (o < 4) ? wg[d * 4 + o] : wr[d * 16 + (o - 4)]; }
    __syncthreads();
    for (int ck = bx; ck < T / 64; ck += G) {
        if (tid < 16) lcnt[tid] = 0;
        __syncthreads();
        for (int it = 0; it < 4; ++it) {
            const int r0 = wave * 8 + it * 2; const size_t m0 = (size_t)ck * 64 + r0;
            f32x4 v0[4], v1[4]; float ss0 = 0.f, ss1 = 0.f;
#pragma unroll
            for (int j = 0; j < 4; ++j) { v0[j] = ((const f32x4*)(h + m0 * D))[64 * j + lane]; v1[j] = ((const f32x4*)(h + (m0 + 1) * D))[64 * j + lane];
                ss0 += (v0[j][0] * v0[j][0] + v0[j][1] * v0[j][1]) + (v0[j][2] * v0[j][2] + v0[j][3] * v0[j][3]);
                ss1 += (v1[j][0] * v1[j][0] + v1[j][1] * v1[j][1]) + (v1[j][2] * v1[j][2] + v1[j][3] * v1[j][3]); }
            const float rs0 = rsqrtf(wave_sum(ss0) * (1.0f / D) + EPS), rs1 = rsqrtf(wave_sum(ss1) * (1.0f / D) + EPS);
#pragma unroll
            for (int j = 0; j < 4; ++j) { const f32x4 gg = ((const f32x4*)g)[64 * j + lane]; v0[j] = v0[j] * rs0 * gg; v1[j] = v1[j] * rs1 * gg;
                u32x2 w; w.x = cvt_pk_bf16(v0[j][0], v0[j][1]); w.y = cvt_pk_bf16(v0[j][2], v0[j][3]); ((u32x2*)(hn + m0 * D))[64 * j + lane] = w;
                w.x = cvt_pk_bf16(v1[j][0], v1[j][1]); w.y = cvt_pk_bf16(v1[j][2], v1[j][3]); ((u32x2*)(hn + (m0 + 1) * D))[64 * j + lane] = w; }
            float a0[20], a1[20];
#pragma unroll
            for (int o = 0; o < 20; ++o) { float s0 = 0.f, s1 = 0.f;
#pragma unroll
                for (int j = 0; j < 4; ++j) { const f32x4 w4 = *(const LAS f32x4*)(WL + o * D + 256 * j + 4 * lane);
                    s0 += (v0[j][0] * w4[0] + v0[j][1] * w4[1]) + (v0[j][2] * w4[2] + v0[j][3] * w4[3]);
                    s1 += (v1[j][0] * w4[0] + v1[j][1] * w4[1]) + (v1[j][2] * w4[2] + v1[j][3] * w4[3]); }
                a0[o] = wave_sum(s0); a1[o] = wave_sum(s1); }
#pragma unroll
            for (int rr = 0; rr < 2; ++rr) {
                float acc[20];
#pragma unroll
                for (int o = 0; o < 20; ++o) acc[o] = rr ? a1[o] : a0[o];
                int gi = 0; float gm = acc[0];
#pragma unroll
                for (int o = 1; o < 4; ++o) if (acc[o] > gm) { gm = acc[o]; gi = o; }
                float gs = 0.f;
#pragma unroll
                for (int o = 0; o < 4; ++o) gs += __expf(acc[o] - gm);
                const float gwt = 1.0f / gs;
                float e[4];
#pragma unroll
                for (int k = 0; k < 4; ++k) { e[k] = acc[4 + k];
#pragma unroll
                    for (int q = 1; q < 4; ++q) if (gi == q) e[k] = acc[4 + q * 4 + k]; }
                int i1 = 0; float x1 = e[0];
#pragma unroll
                for (int k = 1; k < 4; ++k) if (e[k] > x1) { x1 = e[k]; i1 = k; }
                int i2 = 0; float x2 = -INFINITY;
#pragma unroll
                for (int k = 0; k < 4; ++k) if (k != i1 && e[k] > x2) { x2 = e[k]; i2 = k; }
                const float ex = __expf(x2 - x1); const float w1 = gwt / (1.0f + ex), w2 = w1 * ex;
                if (lane == 0) { const int e0 = gi * 4 + i1, e1 = gi * 4 + i2, rl = r0 + rr;
                    const int k0 = __hip_atomic_fetch_add(lcnt + e0, 1, __ATOMIC_RELAXED, __HIP_MEMORY_SCOPE_WORKGROUP);
                    const int k1 = __hip_atomic_fetch_add(lcnt + e1, 1, __ATOMIC_RELAXED, __HIP_MEMORY_SCOPE_WORKGROUP);
                    rinfo[rl * 4] = e0; rinfo[rl * 4 + 1] = k0; rinfo[rl * 4 + 2] = e1; rinfo[rl * 4 + 3] = k1; rw[rl * 2] = w1; rw[rl * 2 + 1] = w2; }
            }
        }
        __syncthreads();
        if (tid < 16) { const int cn = lcnt[tid]; lbase[tid] = cn ? (int)__hip_atomic_fetch_add(gcnt + tid, (unsigned)cn, __ATOMIC_RELAXED, __HIP_MEMORY_SCOPE_AGENT) : 0; }
        __syncthreads();
        if (tid < 64) { const int t = ck * 64 + tid; const int e0 = rinfo[tid * 4], k0 = rinfo[tid * 4 + 1], e1 = rinfo[tid * 4 + 2], k1 = rinfo[tid * 4 + 3];
            list[(size_t)e0 * T + lbase[e0] + k0] = 2 * t; list[(size_t)e1 * T + lbase[e1] + k1] = 2 * t + 1; ew[2 * t] = rw[tid * 2]; ew[2 * t + 1] = rw[tid * 2 + 1]; }
        __syncthreads();
    }
}
__device__ __forceinline__ void moe_table(LAS unsigned char* lds, unsigned* gcnt, bool leader) {
    LAS int* tab = (LAS int*)(lds + RT_TAB);
    if (leader) { int pre = 0;
        for (int e = 0; e < 16; ++e) { const int cn = (int)__hip_atomic_load(gcnt + e, __ATOMIC_RELAXED, __HIP_MEMORY_SCOPE_AGENT); tab[e] = cn; tab[16 + e] = pre; pre += (cn + 255) >> 8; }
        tab[32] = pre; }
    __syncthreads();
}

__global__ void __launch_bounds__(NTHR, 2) mega(Args args) {
    extern __shared__ __attribute__((aligned(16))) unsigned char lds_raw[];
    LAS unsigned char* lds = (LAS unsigned char*)lds_raw;
    const int wave = __builtin_amdgcn_readfirstlane(threadIdx.x >> 6);
#define TID() (wave * 64 + lane_id())
#define LEADER() (wave == 0 && lane_id() == 0)
    const int G = gridDim.x, bx = blockIdx.x;
    unsigned char* ws = args.ws;
    unsigned* ctl = (unsigned*)(ws + WS_CTL);
    for (int u = TID(); u < (LDS_BYTES - LDSCTL_OFF) / 4; u += NTHR) ((LAS unsigned*)(lds + LDSCTL_OFF))[u] = 0u;
    __syncthreads();
    volatile LAS unsigned* MISC = (volatile LAS unsigned*)(lds + LDSCTL_OFF + 320);
    const unsigned phm = (unsigned)args.ph_mask, sem = (unsigned)args.seam_mask;
    XcdBarrier bar; bar.bar = ctl + CW_BAR + args.li * XCD_BAR_WORDS; bar.x = 0; bar.st = nullptr;
    if (sem) bar = xcd_barrier_post(ctl + CW_BAR + args.li * XCD_BAR_WORDS, MISC + 8, LEADER());
#ifndef PHASE_MASK
#define PHASE_MASK 0xffff
#endif
#define IN(k) (((PHASE_MASK >> (k)) & 1) && ((phm >> (k)) & 1u))
#define SEAM(k) do { if ((sem >> (k)) & 1u) xcd_barrier(bar, LEADER()); } while (0)
    const int gw = bx * NWAVES + wave, NGW = G * NWAVES;
    float* h = args.out;
    bf16* hn = (bf16*)(ws + WS_HN); bf16* cat = (bf16*)(ws + WS_CAT); bf16* proj = (bf16*)(ws + WS_PROJ);
    bf16* memn = (bf16*)(ws + WS_MEMN); bf16* kvm = (bf16*)(ws + WS_KVM); bf16* wkv = (bf16*)(ws + WS_WKV);
    bf16* gwt = (bf16*)(ws + WS_GW); float* gpar = (float*)(ws + WS_GP);
    bf16* hid = (bf16*)(ws + WS_HID); bf16* y2 = (bf16*)(ws + WS_Y2); int* list = (int*)(ws + WS_LIST); float* ew = (float*)(ws + WS_EW);
    float* sumA = (float*)(ws + WS_SUM); float* sumB = sumA + (size_t)NB * RG_NCH * TW;

    if (IN(K_PRO)) {
        LAS float* scr = (LAS float*)(lds + wave * 16384);
        for (int i = 0; i < 4; ++i) {
            const int j = i >> 1, nin = (i & 1) ? INB : INA, n_win = 16 * (nin / 32);
            const int n_items = n_win + 512 + 256 + 3 * 2048;
            unsigned char* wl = ws + WS_W + (size_t)i * W_LAYER;
            const float* win = (i & 1) ? args.in[I_WINB] + (size_t)j * D * INB : args.in[I_WINA] + (size_t)j * D * INA;
            for (int it = gw; it < n_items; it += NGW) {
                int r = it;
                if (r < n_win) { const int nblk = nin / 32, kb = r / nblk, nb = r % nblk, n0 = 32 * nb;
                    const bool isq = (i & 1) ? (n0 < 768 || n0 >= 2304) : (n0 >= 1536);
                    transpose_item(win, nin, 64 * kb, n0, (bf16*)(wl + W_IN), D, n0, isq ? 0.125f * att::LOG2E : 1.0f, scr, lane_id()); continue; } r -= n_win;
                if (r < 512) { const int kb = r / 32, nb = r % 32; transpose_item(args.in[I_WOUT] + (size_t)i * D * D, D, 64 * kb, 32 * nb, (bf16*)(wl + W_OUT), D, 32 * nb, 1.0f, scr, lane_id()); continue; } r -= 512;
                if (r < 256) { const int kb = r / 16, nb = r % 16; transpose_item(args.in[I_WKV] + (size_t)i * D * 512, 512, 64 * kb, 32 * nb, wkv, D, i * 512 + 32 * nb, 1.0f, scr, lane_id()); continue; } r -= 256;
                if (r < 4096) {
                    const int which = r / 2048, rr = r % 2048, e = rr / 128, q = rr % 128, kb = q / 8, nb = q % 8, n0 = 32 * nb;
                    const float* src = (which ? args.in[I_W3] : args.in[I_W1]) + ((size_t)i * NE + e) * D * DE;
                    transpose_item(src, DE, 64 * kb, n0, (bf16*)(wl + W_13) + (size_t)e * 512 * D, D, 256 * (n0 / 128) + 128 * which + (n0 % 128), 1.0f, scr, lane_id()); continue; } r -= 4096;
                { const int e = r / 128, q = r % 128, kb = q / 32, nb = q % 32;
                    transpose_item(args.in[I_W2] + ((size_t)i * NE + e) * DE * D, D, 64 * kb, 32 * nb, (bf16*)(wl + W_2) + (size_t)e * D * DE, DE, 32 * nb, 1.0f, scr, lane_id()); }
            }
        }
        for (int idx = bx * NTHR + TID(); idx < 2 * 2 * 8 * 96 * 96; idx += G * NTHR) {
            const int k = idx % 96, n = (idx / 96) % 96, g = (idx / 9216) % 8, gate = (idx / 73728) % 2, j = idx / 147456;
            const float* src = (gate ? args.in[I_GXW] : args.in[I_GAW]) + (size_t)j * 8 * 9216;
            gwt[idx] = (bf16)(cvt_pk_bf16(src[(g * 96 + k) * 96 + n], 0.f) & 0xffffu);
        }
        for (int idx = bx * NTHR + TID(); idx < 2 * TW; idx += G * NTHR) {
            const int j = idx / TW, c = idx % TW;
            gpar[(j * 3 + 0) * TW + c] = args.in[I_GAB][idx]; gpar[(j * 3 + 1) * TW + c] = args.in[I_GXB][idx];
            const float nl = -args.in[I_LAM][idx];
            gpar[(j * 3 + 2) * TW + c] = -8.0f * (fmaxf(nl, 0.f) + log1pf(expf(-fabsf(nl))));
        }
        for (int m = gw; m < NB * ML; m += NGW) norm_row(args.in[I_MEM] + (size_t)m * D, nullptr, nullptr, nullptr, args.in[I_MNG], memn + (size_t)m * D, nullptr, lane_id());
    }
    SEAM(K_PRO);
    if (IN(K_KVM)) {
        pg8::DenseSched Sd; Sd.init(memn, wkv, NB * ML, 4 * 512, D, G, bx);
        pg8::EpiStoreBf16 E{kvm, 4 * 512};
        pg8::gemm_phase<pg8::EpiStoreBf16, pg8::DenseSched, true>(lds, wave, D, Sd, E);
    }
    SEAM(K_KVM);

    for (int i = args.l_lo; i < args.l_hi; ++i) {
        const int j = i >> 1;
        unsigned char* wl = ws + WS_W + (size_t)i * W_LAYER;
        if (IN(K_N1)) {
            if (i == 0) { for (int m = gw; m < T; m += NGW) norm_row(args.in[I_X] + (size_t)m * D, nullptr, nullptr, nullptr, args.in[I_NMG] + i * D, hn + (size_t)m * D, nullptr, lane_id()); }
            else { for (int m = gw; m < T; m += NGW) norm_row(h + (size_t)m * D, y2 + (size_t)(2 * m) * D, y2 + (size_t)(2 * m + 1) * D, h + (size_t)m * D, args.in[I_NMG] + i * D, hn + (size_t)m * D, nullptr, lane_id()); }
        }
        SEAM(K_N1);
        if (IN(K_G1)) {
            pg8::DenseSched Sd; Sd.init(hn, (const bf16*)(wl + W_IN), T, (i & 1) ? INB : INA, D, G, bx);
            pg8::EpiStoreBf16 E{proj, PLD};
            pg8::gemm_phase<pg8::EpiStoreBf16, pg8::DenseSched, true>(lds, wave, D, Sd, E);
        }
        SEAM(K_G1);
        if (IN(K_M1) && (i & 1)) {
            const float lambda_init = 0.8f - 0.6f * __expf(-0.3f * (float)i);
            att::attn_phase(lds, wave, true, ctl + CW_AQ + 64 * i, MISC + 16, proj, kvm, i, 2304, args.in[I_RELB], args.in[I_LQ1] + j * 64, args.in[I_LK1] + j * 64, args.in[I_LQ2] + j * 64, args.in[I_LK2] + j * 64,
                            args.in[I_SUBG] + j * 128, lambda_init, cat);
        }
        if ((i & 1) == 0) {
            if (IN(K_M1)) {
                for (int u = bx; u < NB * RG_NCH * 8; u += G)
                    rglru_unit<1>(lds, wave, u / (RG_NCH * 8), (u / 8) % RG_NCH, u % 8, proj, args.in[I_CW] + (size_t)j * 4 * TW, args.in[I_CB] + j * TW, gwt + (size_t)j * 2 * 8 * 9216, gpar + (size_t)j * 3 * TW, sumA, sumB, cat);
            }
            if (IN(K_M1)) att::attn_phase(lds, wave, false, ctl + CW_AQ + 64 * i, MISC + 16, proj, kvm, i, 1536, nullptr, nullptr, nullptr, nullptr, nullptr, nullptr, 0.f, cat);
            SEAM(K_M1);
            if (IN(K_M2)) {
                for (int u = bx; u < NB * RG_NCH * 8; u += G)
                    rglru_unit<2>(lds, wave, u / (RG_NCH * 8), (u / 8) % RG_NCH, u % 8, proj, args.in[I_CW] + (size_t)j * 4 * TW, args.in[I_CB] + j * TW, gwt + (size_t)j * 2 * 8 * 9216, gpar + (size_t)j * 3 * TW, sumA, sumB, cat);
            }
            SEAM(K_M2);
        } else { SEAM(K_M1); }
        if (IN(K_G2)) {
            pg8::DenseSched Sd; Sd.init(cat, (const bf16*)(wl + W_OUT), T, D, D, G, bx);
            pg8::EpiResF32 E{(i == 0) ? args.in[I_X] : h, h, D};
            pg8::gemm_phase<pg8::EpiResF32, pg8::DenseSched, true>(lds, wave, D, Sd, E);
        }
        SEAM(K_G2);
        if (IN(K_N2)) route_phase(lds, wave, h, args.in[I_NFG] + i * D, args.in[I_WG] + (size_t)i * D * 4, args.in[I_WR] + (size_t)i * D * 16, hn, ctl + CW_CNT + 64 * i, list, ew, G, bx);
        SEAM(K_N2);
        if (IN(K_E1)) {
            moe_table(lds, ctl + CW_CNT + 64 * i, LEADER());
            pg8::MoeSched Sm{hn, (const bf16*)(wl + W_13), D, (size_t)512 * D * 2, 2, 1, list, (const LAS int*)(lds + RT_TAB), (LAS int*)(lds + GT_TABS), G, bx};
            pg8::EpiMoe1 E{hid, (const LAS int*)(lds + GT_TABS), ew};
            pg8::gemm_phase<pg8::EpiMoe1, pg8::MoeSched, true>(lds, wave, D, Sm, E);
        }
        SEAM(K_E1);
        if (IN(K_E2)) {
            moe_table(lds, ctl + CW_CNT + 64 * i, LEADER());
            pg8::MoeSched Sm{hid, (const bf16*)(wl + W_2), DE, (size_t)D * DE * 2, 4, 0, list, (const LAS int*)(lds + RT_TAB), (LAS int*)(lds + GT_TABS), G, bx};
            pg8::EpiMoe2 E{y2, (const LAS int*)(lds + GT_TABS)};
            pg8::gemm_phase<pg8::EpiMoe2, pg8::MoeSched, true>(lds, wave, DE, Sm, E);
        }
        SEAM(K_E2);
    }
    if (IN(K_FIN)) {
        for (int m = gw; m < T; m += NGW) norm_row(h + (size_t)m * D, y2 + (size_t)(2 * m) * D, y2 + (size_t)(2 * m + 1) * D, nullptr, args.in[I_FNG], nullptr, h + (size_t)m * D, lane_id());
    }
#undef IN
#undef SEAM
#undef TID
#undef LEADER
}

extern "C" void kernel_launch(void* const* d_in, const int* in_sizes, int n_in, void* d_out, int out_size, void* d_ws, size_t ws_size, hipStream_t stream) {
    static int grid = 0;
    if (grid == 0) {
        if (n_in != 28 || out_size != T * D || ws_size < WS_END) { fprintf(stderr, "kernel_launch: unexpected n_in %d / out_size %d / ws_size %zu\n", n_in, out_size, ws_size); grid = -1; return; }
        int dev = 0, cus = 0, per_cu = 0;
        if (hipGetDevice(&dev) != hipSuccess || hipDeviceGetAttribute(&cus, hipDeviceAttributeMultiprocessorCount, dev) != hipSuccess) { grid = -1; return; }
        if (hipFuncSetAttribute((const void*)mega, hipFuncAttributeMaxDynamicSharedMemorySize, LDS_BYTES) != hipSuccess) { fprintf(stderr, "kernel_launch: hipFuncSetAttribute failed\n"); grid = -1; return; }
        if (hipOccupancyMaxActiveBlocksPerMultiprocessor(&per_cu, (const void*)mega, NTHR, LDS_BYTES) != hipSuccess || per_cu < 1) fprintf(stderr, "kernel_launch: occupancy query says %d\n", per_cu);
        (void)hipGetLastError();
        grid = cus;
    }
    if (grid < 0) return;
    (void)hipMemsetAsync((char*)d_ws + WS_CTL, 0, CTL_ZERO_BYTES, stream);
    Args a{};
    for (int i = 0; i < 28; ++i) a.in[i] = (const float*)d_in[i];
    a.out = (float*)d_out; a.ws = (unsigned char*)d_ws;
    a.l_lo = 0; a.l_hi = 4; a.ph_mask = (1 << K_NUM) - 1; a.seam_mask = ((1 << K_NUM) - 1) & ~(1 << K_FIN) & ~(1 << K_KVM); a.li = 0;
    hipLaunchKernelGGL(mega, dim3(grid), dim3(NTHR), LDS_BYTES, stream, a);
}
```

```cpp
#include <hip/hip_runtime.h>
#include <math.h>
#include <stdio.h>
#include <stdint.h>

#define LAS __attribute__((address_space(3)))
#define GAS __attribute__((address_space(1)))
typedef unsigned short bf16;
typedef short bf16x8 __attribute__((ext_vector_type(8)));
typedef float f32x4 __attribute__((ext_vector_type(4)));
typedef unsigned u32x4 __attribute__((ext_vector_type(4)));
typedef unsigned u32x2 __attribute__((ext_vector_type(2)));

constexpr int D = 1024, NB = 2, S = 8192, T = NB * S, ML = 256, TW = 768, INA = 1792, INB = 2560, DE = 256, NE = 16;
constexpr int PLD = 2560;
constexpr float EPS = 1e-6f;
constexpr int NWAVES = 8, NTHR = 512;

constexpr size_t MiB = 1u << 20;
constexpr size_t WS_CTL = 0, CTL_ZERO_BYTES = 65536;
constexpr size_t WS_W = 2 * MiB, W_LAYER = 31 * MiB, W_IN = 0, W_OUT = 5 * MiB, W_13 = 7 * MiB, W_2 = 23 * MiB;
constexpr size_t WS_WKV = 126 * MiB;
constexpr size_t WS_MEMN = 130 * MiB;
constexpr size_t WS_KVM = 131 * MiB;
constexpr size_t WS_HN = 133 * MiB;
constexpr size_t WS_CAT = 165 * MiB;
constexpr size_t WS_PROJ = 197 * MiB;
constexpr size_t WS_HID = 197 * MiB;
constexpr size_t WS_Y2 = 213 * MiB;
constexpr size_t WS_GW = 277 * MiB;
constexpr size_t WS_GP = 278 * MiB;
constexpr size_t WS_SUM = 279 * MiB;
constexpr size_t WS_EID = 281 * MiB;
constexpr size_t WS_EW = 282 * MiB;
constexpr size_t WS_LIST = 283 * MiB;
constexpr size_t WS_END = 284 * MiB;
constexpr int CW_AQ = 1024;
constexpr int CW_CNT = 2048;
constexpr int CW_BAR = 4096;

constexpr int RING_BYTES = 131072, LDSCTL_OFF = RING_BYTES, LDS_BYTES = 163840, MISC_OFF = LDS_BYTES - 256;

__device__ __forceinline__ unsigned cvt_pk_bf16(float lo, float hi) { unsigned r; asm volatile("v_cvt_pk_bf16_f32 %0, %1, %2" : "=v"(r) : "v"(lo), "v"(hi)); return r; }
__device__ __forceinline__ float bf2f(bf16 v) { return __uint_as_float(((unsigned)v) << 16); }
__device__ __forceinline__ float bflo(unsigned w) { return __uint_as_float(w << 16); }
__device__ __forceinline__ float bfhi(unsigned w) { return __uint_as_float(w & 0xffff0000u); }
__device__ __forceinline__ int lane_id() { int l = (int)__builtin_amdgcn_mbcnt_hi(~0u, __builtin_amdgcn_mbcnt_lo(~0u, 0u)); asm volatile("" : "+v"(l)); return l; }
__device__ __forceinline__ float wave_sum(float v) {
#pragma unroll
    for (int o = 1; o < 64; o <<= 1) v += __shfl_xor(v, o);
    return v;
}
__device__ __forceinline__ float wave_max(float v) {
#pragma unroll
    for (int o = 1; o < 64; o <<= 1) v = fmaxf(v, __shfl_xor(v, o));
    return v;
}
__device__ __forceinline__ float fast_sigmoid(float x) { return __builtin_amdgcn_rcpf(1.0f + __expf(-x)); }
__device__ __forceinline__ float gelu_tanh_fast(float x) {
    const float u = 0.7978845608028654f * (x + 0.044715f * x * x * x);
    return x * fast_sigmoid(2.0f * u);
}

__device__ const unsigned char BUCKET[128] = {
    0, 1, 2, 3, 4, 5, 6, 7, 8, 9, 10, 11, 12, 13, 14, 15, 16, 16, 16, 17, 17, 18, 18, 18, 19, 19, 19, 20, 20, 20, 20, 21, 21, 21, 21, 22, 22, 22, 22, 22,
    23, 23, 23, 23, 23, 23, 24, 24, 24, 24, 24, 24, 25, 25, 25, 25, 25, 25, 25, 26, 26, 26, 26, 26, 26, 26, 26, 27, 27, 27, 27, 27, 27, 27, 27, 27, 27,
    28, 28, 28, 28, 28, 28, 28, 28, 28, 28, 29, 29, 29, 29, 29, 29, 29, 29, 29, 29, 29, 29, 30, 30, 30, 30, 30, 30, 30, 30, 30, 30, 30, 30, 30, 30,
    31, 31, 31, 31, 31, 31, 31, 31, 31, 31, 31, 31, 31, 31, 31};

#define XB_TMO      128
#define XB_XCNT(j)  (256  + 64 * (j))
#define XB_XSUB(j)  (1280 + 64 * (j))
#define XB_XGEN(j)  (2304 + 64 * (j))
#define XB_TOP      3328
#define XB_TOPGEN   3392
#define XCD_BAR_WORDS 3456
#define XB_SPIN_CAP (1u << 22)

__device__ __forceinline__ unsigned xb_ld(unsigned* p)              { return __hip_atomic_load(p, __ATOMIC_RELAXED, __HIP_MEMORY_SCOPE_AGENT); }
__device__ __forceinline__ unsigned xb_add(unsigned* p, unsigned v) { return __hip_atomic_fetch_add(p, v, __ATOMIC_RELAXED, __HIP_MEMORY_SCOPE_AGENT); }
__device__ __forceinline__ unsigned xb_xcc_id() { return (unsigned)__builtin_amdgcn_s_getreg((3 << 11) | 20) & 0xFu; }
#define XB_SPIN(cond, bar) do { unsigned _sp = 0; while (cond) { __builtin_amdgcn_s_sleep(1); \
    if ((++_sp & 255u) == 0u) { if (xb_ld(&(bar)[XB_TMO])) break; if (_sp > XB_SPIN_CAP) { atomicAdd(&(bar)[XB_TMO], 1u); break; } } } } while (0)

struct XcdBarrier { unsigned* bar; unsigned x; volatile LAS unsigned* st; };

__device__ __forceinline__ XcdBarrier xcd_barrier_post(unsigned* bar, volatile LAS unsigned* st, bool leader) {
    XcdBarrier b; b.bar = bar; b.x = xb_xcc_id(); b.st = st;
    if (leader) (void)xb_add(&bar[XB_XCNT(b.x)], 1u);
    return b;
}
__device__ __forceinline__ void xcd_barrier_complete(unsigned* bar, unsigned x, unsigned& nloc, unsigned& nx) {
    const unsigned G = gridDim.x * gridDim.y * gridDim.z;
    unsigned sum, cnt, mine, sp = 0u;
    for (;;) {
        sum = 0u; cnt = 0u; mine = 0u;
#pragma unroll
        for (unsigned j = 0; j < 16; ++j) { const unsigned c = xb_ld(&bar[XB_XCNT(j)]); sum += c; cnt += (c > 0u) ? 1u : 0u; mine = (j == x) ? c : mine; }
        if (sum == G) break;
        __builtin_amdgcn_s_sleep(1);
        if ((++sp & 255u) == 0u) { if (xb_ld(&bar[XB_TMO])) break; if (sp > XB_SPIN_CAP) { atomicAdd(&bar[XB_TMO], 1u); break; } }
    }
    nloc = mine > 0u ? mine : 1u; nx = cnt > 0u ? cnt : 1u;
}
__device__ __forceinline__ void xcd_barrier(const XcdBarrier& b, bool leader) {
    asm volatile("s_waitcnt vmcnt(0)" ::: "memory");
    __syncthreads();
    if (leader) {
        unsigned* bar = b.bar;
        __builtin_amdgcn_s_waitcnt(0);
        unsigned nloc = b.st[0], nx = b.st[1];
        if (nloc == 0u) { xcd_barrier_complete(bar, b.x, nloc, nx); b.st[0] = nloc; b.st[1] = nx; }
        const unsigned old = xb_add(&bar[XB_XSUB(b.x)], 1u);
        const unsigned gen = old / nloc;
        if (old + 1u == (gen + 1u) * nloc) {
            __builtin_amdgcn_fence(__ATOMIC_RELEASE, "agent");
            asm volatile("s_waitcnt vmcnt(0)" ::: "memory");
            const unsigned og = xb_add(&bar[XB_TOP], 1u);
            const unsigned tg = og / nx;
            if (og + 1u == (tg + 1u) * nx) xb_add(&bar[XB_TOPGEN], 1u);
            else XB_SPIN(xb_ld(&bar[XB_TOPGEN]) == tg, bar);
            __builtin_amdgcn_fence(__ATOMIC_ACQUIRE, "agent");
            xb_add(&bar[XB_XGEN(b.x)], 1u);
            asm volatile("s_waitcnt vmcnt(0)" ::: "memory");
        } else {
            XB_SPIN(xb_ld(&bar[XB_XGEN(b.x)]) == gen, bar);
            __builtin_amdgcn_fence(__ATOMIC_ACQUIRE, "agent");
            asm volatile("s_waitcnt vmcnt(0)" ::: "memory");
        }
    }
    __syncthreads();
}

namespace pg8 {
constexpr int BM = 256, BK = 64, HALF = 128, HTB = HALF * BK * 2, STAGE_BYTES = 8 * HTB, NXCD = 8, WGM = 8;
__host__ __device__ __forceinline__ int lds_byte(int r, int c) { const int st = (r >> 4) * 2 + (c >> 5), rr = r & 15, cc = c & 31, ob = rr * 64 + cc * 2; return st * 1024 + (ob ^ (((ob >> 9) & 1) << 5)); }
__host__ __device__ __forceinline__ void stage_rc(int b, int& R, int& C) { const int st = b / 1024, sb = b % 1024, swz = sb ^ (((sb >> 9) & 1) << 5); R = (st >> 1) * 16 + swz / 64; C = (st & 1) * 32 + (swz % 64) / 2; }
__host__ __device__ __forceinline__ int perm32(int rho) { const int n = rho >> 4, i = rho & 15; return 8 * (i >> 2) + 4 * n + (i & 3); }

struct Unit { int pm, pn, e, cnt, par; };

struct DenseSched {
    static constexpr bool GATHER = false;
    const bf16* A; const bf16* Bt; int K, nM, nN, nwg, G, c;
    __device__ void init(const bf16* A_, const bf16* Bt_, int M, int N, int K_, int G_, int c_) { A = A_; Bt = Bt_; K = K_; nM = M / BM; nN = N / BM; nwg = nM * nN; G = G_; c = c_; }
    __device__ __forceinline__ bool next(int i, Unit& u) const {
        const long L = (long)i * G + c; if (L >= nwg) return false;
        int wgid = (int)L; { const int q = nwg / NXCD, r = nwg % NXCD, xcd = wgid % NXCD, off = wgid / NXCD; wgid = (xcd < r ? xcd * (q + 1) : r * (q + 1) + (xcd - r) * q) + off; }
        const int nig = WGM * nN, gid = wgid / nig, fm = gid * WGM, gsz = (nM - fm) < WGM ? (nM - fm) : WGM;
        u.pm = fm + ((wgid % nig) % gsz); u.pn = (wgid % nig) / gsz; u.e = 0; u.cnt = BM; u.par = 0; return true;
    }
    __device__ __forceinline__ const char* a_base(const Unit& u) const { return (const char*)A + (size_t)u.pm * BM * K * 2; }
    __device__ __forceinline__ const char* b_base(const Unit& u) const { return (const char*)Bt + (size_t)u.pn * BM * K * 2; }
};

template <class Epi, class Sched, bool ALIGN_EPI>
__device__ __forceinline__ void gemm_phase(LAS unsigned char* lds, const int wid, const int K, const Sched& S, const Epi& E) {
    const int lane = lane_id(), tid = wid * 64 + lane, wr = wid >> 2, wc = wid & 3, fr = lane & 15, fq = lane >> 4;
    const int nt = K / BK;
    int Rr[2], Cc[2]; unsigned voffB[2];
#pragma unroll
    for (int i = 0; i < 2; ++i) { int R, C; stage_rc(tid * 16 + i * 8192, R, C); Rr[i] = R; Cc[i] = C; const int Rb = Epi::PERM ? ((R & ~31) + perm32(R & 31)) : R;
        voffB[i] = (unsigned)(Rb * K + C) * 2u; }
    const size_t kstep = (size_t)(BK * 2);
    const size_t hstep = (size_t)HALF * K * 2;
    const unsigned ldsw = (unsigned)wid * 1024u;
    const int aoff = lds_byte(wr * 64 + fr, fq * 8), boff = lds_byte(wc * 32 + fr, fq * 8);
#define PG8_SA(b, h) (((b) * 2 + (h)) * HTB)
#define PG8_SB(b, h) ((4 + (b) * 2 + (h)) * HTB)
#define PG8_STAGE(bufoff, gbase, voff) do { _Pragma("unroll") for (int _i = 0; _i < 2; ++_i) \
        __builtin_amdgcn_global_load_lds((const unsigned*)((const char*)(gbase) + (voff)[_i]), (LAS unsigned*)(lds + (bufoff) + ldsw + _i * 8192), 16, 0, 0); } while (0)
#define PG8_LDA(dst, b, h) do { _Pragma("unroll") for (int m = 0; m < 4; ++m) _Pragma("unroll") for (int k = 0; k < 2; ++k) dst[m][k] = *(const LAS bf16x8*)(lds + PG8_SA(b, h) + aoff + m * 2048 + k * 1024); } while (0)
#define PG8_LDB(dst, b, h) do { _Pragma("unroll") for (int n = 0; n < 2; ++n) _Pragma("unroll") for (int k = 0; k < 2; ++k) dst[n][k] = *(const LAS bf16x8*)(lds + PG8_SB(b, h) + boff + n * 2048 + k * 1024); } while (0)
#define PG8_MMA(ai, bj, At, Bt) do { __builtin_amdgcn_s_setprio(1); _Pragma("unroll") for (int m = 0; m < 4; ++m) _Pragma("unroll") for (int n = 0; n < 2; ++n) _Pragma("unroll") for (int k = 0; k < 2; ++k) \
        acc[ai][bj][m][n] = __builtin_amdgcn_mfma_f32_16x16x32_bf16(Bt[n][k], At[m][k], acc[ai][bj][m][n], 0, 0, 0); __builtin_amdgcn_s_setprio(0); } while (0)
#define PG8_WAIT_V(n) asm volatile("s_waitcnt vmcnt(" #n ")" ::: "memory")
#define PG8_WAIT_L(n) asm volatile("s_waitcnt lgkmcnt(" #n ")" ::: "memory")
#define PG8_BAR __builtin_amdgcn_s_barrier()
#define PG8_SCHED __builtin_amdgcn_sched_barrier(0)
    Unit cur, nxt; int ui = 0;
    if (!S.next(0, cur)) return;
    cur.par = 0;
    f32x4 acc[2][2][4][2];
#pragma unroll
    for (int a = 0; a < 2; ++a)
#pragma unroll
        for (int b = 0; b < 2; ++b)
#pragma unroll
            for (int m = 0; m < 4; ++m)
#pragma unroll
                for (int n = 0; n < 2; ++n) acc[a][b][m][n] = (f32x4){0.f, 0.f, 0.f, 0.f};
    bf16x8 At[4][2], B0[2][2], B1[2][2];
    unsigned vAd[2][2];
#pragma unroll
    for (int h = 0; h < 2; ++h)
#pragma unroll
        for (int i = 0; i < 2; ++i) vAd[h][i] = (unsigned)((h * HALF + Rr[i]) * K + Cc[i]) * 2u;
    if constexpr (Sched::GATHER) { if (wid < 4) S.dma_slots(cur, 0, wid, tid); PG8_WAIT_V(0); __syncthreads(); }
#define PG8_STAGE_A(bufoff, gbase, par, h) do { if constexpr (Sched::GATHER) { unsigned _v[2]; _Pragma("unroll") for (int _i = 0; _i < 2; ++_i) _v[_i] = S.row_off(S.tabS[(par) * 256 + (h) * HALF + Rr[_i]]) + (unsigned)Cc[_i] * 2u; \
        PG8_WAIT_L(0); PG8_STAGE(bufoff, gbase, _v); } else { PG8_STAGE(bufoff, gbase, vAd[h]); } } while (0)
    const char* cA = S.a_base(cur); const char* cB = S.b_base(cur);
    PG8_STAGE(PG8_SB(0, 0), cB, voffB); PG8_STAGE(PG8_SB(0, 1), cB + hstep, voffB); PG8_STAGE_A(PG8_SA(0, 0), cA, 0, 0); PG8_STAGE_A(PG8_SA(0, 1), cA, 0, 1);
    if (wr == 1) PG8_BAR;
    PG8_WAIT_V(2); PG8_BAR;
    PG8_STAGE(PG8_SB(1, 0), cB + kstep, voffB); PG8_STAGE_A(PG8_SA(1, 0), cA + kstep, 0, 0); PG8_STAGE(PG8_SB(1, 1), cB + hstep + kstep, voffB);
    PG8_WAIT_V(6); PG8_BAR;
    for (;;) {
        const bool has_next = S.next(ui + 1, nxt);
        const int pc = ui & 1, pn_ = pc ^ 1;
        nxt.par = pn_;
        const char* nA = has_next ? S.a_base(nxt) : cA; const char* nB = has_next ? S.b_base(nxt) : cB;
#pragma nounroll
        for (int t = 0; t < nt; t += 2) {
            const bool last = (t == nt - 2);
            const char* a1 = cA + (size_t)(t + 1) * kstep;
            const char* a2 = last ? nA : cA + (size_t)(t + 2) * kstep; const char* b2 = last ? nB : cB + (size_t)(t + 2) * kstep;
            const char* a3 = a2 + kstep; const char* b3 = b2 + kstep;
            const int p2 = (last && has_next) ? pn_ : pc;
            PG8_LDB(B0, 0, 0); PG8_LDB(B1, 0, 1); PG8_SCHED; PG8_LDA(At, 0, 0); PG8_STAGE_A(PG8_SA(1, 1), a1, pc, 1);
            PG8_WAIT_V(8); PG8_WAIT_L(0); PG8_BAR; PG8_MMA(0, 0, At, B0); PG8_MMA(0, 1, At, B1); PG8_BAR; PG8_SCHED;
            PG8_LDA(At, 0, 1); PG8_STAGE(PG8_SB(0, 0), b2, voffB); PG8_STAGE(PG8_SB(0, 1), b2 + hstep, voffB); PG8_STAGE_A(PG8_SA(0, 0), a2, p2, 0);
            PG8_WAIT_V(8); PG8_WAIT_L(0); PG8_BAR; PG8_MMA(1, 0, At, B0); PG8_MMA(1, 1, At, B1); PG8_BAR; PG8_SCHED;
            if constexpr (Sched::GATHER) { if (t == 0 && has_next && wid < 4) S.dma_slots(nxt, pn_, wid, tid); }
            PG8_LDB(B0, 1, 0); PG8_LDB(B1, 1, 1); PG8_SCHED; PG8_LDA(At, 1, 0); PG8_STAGE_A(PG8_SA(0, 1), a2, p2, 1);
            PG8_WAIT_V(8); PG8_WAIT_L(0); PG8_BAR; PG8_MMA(0, 0, At, B0); PG8_MMA(0, 1, At, B1); PG8_BAR; PG8_SCHED;
            PG8_LDA(At, 1, 1); PG8_STAGE(PG8_SB(1, 0), b3, voffB); PG8_STAGE(PG8_SB(1, 1), b3 + hstep, voffB); PG8_STAGE_A(PG8_SA(1, 0), a3, p2, 0);
            PG8_WAIT_V(8); PG8_WAIT_L(0); PG8_BAR; PG8_MMA(1, 0, At, B0); PG8_MMA(1, 1, At, B1); PG8_BAR; PG8_SCHED;
        }
        if constexpr (ALIGN_EPI) { if (wr == 0) PG8_BAR; }
        E(acc, cur, wr, wc, fr, fq);
        if (!has_next) break;
#pragma unroll
        for (int a = 0; a < 2; ++a)
#pragma unroll
            for (int b = 0; b < 2; ++b)
#pragma unroll
                for (int m = 0; m < 4; ++m)
#pragma unroll
                    for (int n = 0; n < 2; ++n) acc[a][b][m][n] = (f32x4){0.f, 0.f, 0.f, 0.f};
        cur = nxt; cA = nA; cB = nB; ++ui;
        if constexpr (ALIGN_EPI) { if (wr == 1) PG8_BAR; }
    }
    PG8_WAIT_V(0);
    if constexpr (!ALIGN_EPI) { if (wr == 0) PG8_BAR; }
    PG8_BAR;
#undef PG8_SA
#undef PG8_SB
#undef PG8_STAGE
#undef PG8_STAGE_A
#undef PG8_LDA
#undef PG8_LDB
#undef PG8_MMA
#undef PG8_WAIT_V
#undef PG8_WAIT_L
#undef PG8_BAR
#undef PG8_SCHED
}

struct EpiStoreBf16 {
    static constexpr bool PERM = true;
    bf16* O; int ldc;
    __device__ __forceinline__ void operator()(const f32x4 (&acc)[2][2][4][2], const Unit& u, int wr, int wc, int fr, int fq) const {
        const int row0 = u.pm * BM + wr * 64 + fr, col0 = u.pn * BM + wc * 32 + 8 * fq;
#pragma unroll
        for (int ai = 0; ai < 2; ++ai)
#pragma unroll
            for (int m = 0; m < 4; ++m) { bf16* rowp = O + (size_t)(row0 + ai * HALF + m * 16) * ldc + col0;
#pragma unroll
                for (int bj = 0; bj < 2; ++bj) { const f32x4 v0 = acc[ai][bj][m][0], v1 = acc[ai][bj][m][1];
                    u32x4 w; w.x = cvt_pk_bf16(v0[0], v0[1]); w.y = cvt_pk_bf16(v0[2], v0[3]); w.z = cvt_pk_bf16(v1[0], v1[1]); w.w = cvt_pk_bf16(v1[2], v1[3]);
                    *(u32x4*)(rowp + bj * HALF) = w; } }
    }
};
struct EpiResF32 {
    static constexpr bool PERM = false;
    const float* base; float* out; int ldc;
    __device__ __forceinline__ void operator()(const f32x4 (&acc)[2][2][4][2], const Unit& u, int wr, int wc, int fr, int fq) const {
        const int col0 = u.pn * BM + wc * 32 + 4 * fq;
#pragma unroll
        for (int ai = 0; ai < 2; ++ai)
#pragma unroll
            for (int m = 0; m < 4; ++m) { const size_t off = (size_t)(u.pm * BM + ai * HALF + wr * 64 + m * 16 + fr) * ldc + col0;
#pragma unroll
                for (int bj = 0; bj < 2; ++bj)
#pragma unroll
                    for (int n = 0; n < 2; ++n) { const f32x4 bs = *(const f32x4*)(base + off + bj * HALF + n * 16); *(f32x4*)(out + off + bj * HALF + n * 16) = bs + acc[ai][bj][m][n]; }
                if (m & 1) asm volatile("" ::: "memory"); }
    }
};
struct MoeSched {
    static constexpr bool GATHER = true;
    const bf16* A; const bf16* Bt; int K; size_t bt_estride; int npn, shift; const int* list; const LAS int* tab  ;
    LAS int* tabS  ; int G, c;
    __device__ __forceinline__ bool next(int i, Unit& u) const {
        const int L = i * G + c, nu = __builtin_amdgcn_readfirstlane(tab[32]) * npn; if (L >= nu) return false;
        const int ti = L / npn; u.pn = L % npn; int e = 0;
#pragma unroll
        for (int k = 1; k < 16; ++k) if (ti >= __builtin_amdgcn_readfirstlane(tab[16 + k])) e = k;
        u.e = e; u.pm = ti - __builtin_amdgcn_readfirstlane(tab[16 + e]); const int rem = __builtin_amdgcn_readfirstlane(tab[e]) - BM * u.pm; u.cnt = rem < BM ? rem : BM; u.par = 0; return true;
    }
    __device__ __forceinline__ const char* a_base(const Unit&) const { return (const char*)A; }
    __device__ __forceinline__ const char* b_base(const Unit& u) const { return (const char*)Bt + (size_t)u.e * bt_estride + (size_t)u.pn * BM * K * 2; }
    __device__ __forceinline__ void dma_slots(const Unit& u, int par, int wid, int tid) const {
        const int rr = tid < u.cnt ? tid : u.cnt - 1;
        __builtin_amdgcn_global_load_lds((const unsigned*)(list + (size_t)u.e * T + BM * u.pm + rr), (LAS unsigned*)(tabS + par * 256 + wid * 64), 4, 0, 0); }
    __device__ __forceinline__ unsigned row_off(int slot) const { return (unsigned)(slot >> shift) * (unsigned)(K * 2); }
};
struct EpiMoe1 {
    static constexpr bool PERM = true;
    bf16* hid; const LAS int* tabS; const float* ew;
    __device__ __forceinline__ void operator()(const f32x4 (&acc)[2][2][4][2], const Unit& u, int wr, int wc, int fr, int fq) const {
#pragma unroll
        for (int ai = 0; ai < 2; ++ai)
#pragma unroll
            for (int m = 0; m < 4; ++m) { const int r = ai * HALF + wr * 64 + m * 16 + fr;
                const int slot = tabS[u.par * 256 + r];
                if (r < u.cnt) { const float w = ew[slot];
                    float hv[8];
#pragma unroll
                    for (int n = 0; n < 2; ++n)
#pragma unroll
                        for (int k = 0; k < 4; ++k) { const float a = acc[ai][0][m][n][k], uu = acc[ai][1][m][n][k]; hv[4 * n + k] = a * __builtin_amdgcn_rcpf(1.0f + __expf(-a)) * uu * w; }
                    u32x4 o; o.x = cvt_pk_bf16(hv[0], hv[1]); o.y = cvt_pk_bf16(hv[2], hv[3]); o.z = cvt_pk_bf16(hv[4], hv[5]); o.w = cvt_pk_bf16(hv[6], hv[7]);
                    *(u32x4*)(hid + (size_t)slot * DE + u.pn * HALF + wc * 32 + 8 * fq) = o; } }
    }
};
struct EpiMoe2 {
    static constexpr bool PERM = true;
    bf16* y2; const LAS int* tabS;
    __device__ __forceinline__ void operator()(const f32x4 (&acc)[2][2][4][2], const Unit& u, int wr, int wc, int fr, int fq) const {
#pragma unroll
        for (int ai = 0; ai < 2; ++ai)
#pragma unroll
            for (int m = 0; m < 4; ++m) { const int r = ai * HALF + wr * 64 + m * 16 + fr;
                const int slot = tabS[u.par * 256 + r];
                if (r < u.cnt) {
                    bf16* rowp = y2 + (size_t)slot * D + u.pn * BM + wc * 32 + 8 * fq;
#pragma unroll
                    for (int bj = 0; bj < 2; ++bj) { const f32x4 v0 = acc[ai][bj][m][0], v1 = acc[ai][bj][m][1];
                        u32x4 o; o.x = cvt_pk_bf16(v0[0], v0[1]); o.y = cvt_pk_bf16(v0[2], v0[3]); o.z = cvt_pk_bf16(v1[0], v1[1]); o.w = cvt_pk_bf16(v1[2], v1[3]);
                        *(u32x4*)(rowp + bj * HALF) = o; } } }
    }
};
}

struct Args { const float* in[28]; float* out; unsigned char* ws; int ph_mask, seam_mask, l_lo, l_hi, li, pad; };
enum { I_X = 0, I_MEM, I_NMG, I_WINA, I_WINB, I_WOUT, I_CW, I_CB, I_GAW, I_GAB, I_GXW, I_GXB, I_LAM, I_LQ1, I_LK1, I_LQ2, I_LK2, I_SUBG, I_RELB, I_MNG, I_WKV, I_NFG, I_WG, I_WR, I_W1, I_W3, I_W2, I_FNG };
enum { K_PRO = 0, K_KVM, K_N1, K_G1, K_M1, K_M2, K_G2, K_N2, K_E1, K_E2, K_FIN, K_NUM };

__device__ __forceinline__ void transpose_item(const float* W, int ldw, int k0, int nsrc0, bf16* WT, int ldt, int drow0, float scale, LAS float* scr, int lane) {
#pragma unroll 8
    for (int i = 0; i < 32; ++i) { const int kk = 2 * i + (lane >> 5); scr[kk * 33 + (lane & 31)] = W[(size_t)(k0 + kk) * ldw + nsrc0 + (lane & 31)] * scale; }
    asm volatile("s_waitcnt lgkmcnt(0)" ::: "memory");
    const int c = lane & 7;
#pragma unroll
    for (int j = 0; j < 4; ++j) { const int n = (lane >> 3) + 8 * j; const LAS float* s = scr + (8 * c) * 33 + n;
        u32x4 o; o.x = cvt_pk_bf16(s[0 * 33], s[1 * 33]); o.y = cvt_pk_bf16(s[2 * 33], s[3 * 33]); o.z = cvt_pk_bf16(s[4 * 33], s[5 * 33]); o.w = cvt_pk_bf16(s[6 * 33], s[7 * 33]);
        *(u32x4*)(WT + (size_t)(drow0 + n) * ldt + k0 + 8 * c) = o; }
    asm volatile("s_waitcnt lgkmcnt(0)" ::: "memory");
}
__device__ __forceinline__ void norm_row(const float* xrow, const bf16* y0, const bf16* y1, float* hrow_out, const float* g, bf16* orow, float* frow, int lane) {
    asm volatile("" : "+v"(lane));
    f32x4 v[4]; float ss = 0.f;
#pragma unroll
    for (int j = 0; j < 4; ++j) {
        v[j] = ((const f32x4*)xrow)[64 * j + lane];
        if (y0) { const u32x2 a = ((const u32x2*)y0)[64 * j + lane], b = ((const u32x2*)y1)[64 * j + lane];
            v[j][0] += bflo(a.x) + bflo(b.x); v[j][1] += bfhi(a.x) + bfhi(b.x); v[j][2] += bflo(a.y) + bflo(b.y); v[j][3] += bfhi(a.y) + bfhi(b.y); }
        ss += (v[j][0] * v[j][0] + v[j][1] * v[j][1]) + (v[j][2] * v[j][2] + v[j][3] * v[j][3]);
    }
    if (hrow_out) {
#pragma unroll
        for (int j = 0; j < 4; ++j) ((f32x4*)hrow_out)[64 * j + lane] = v[j];
    }
    const float r = rsqrtf(wave_sum(ss) * (1.0f / D) + EPS);
#pragma unroll
    for (int j = 0; j < 4; ++j) {
        const f32x4 gg = ((const f32x4*)g)[64 * j + lane];
        const f32x4 o = v[j] * r * gg;
        if (orow) { u32x2 w; w.x = cvt_pk_bf16(o[0], o[1]); w.y = cvt_pk_bf16(o[2], o[3]); ((u32x2*)orow)[64 * j + lane] = w; }
        if (frow) ((f32x4*)frow)[64 * j + lane] = o;
    }
}

constexpr int RG_L = 128, RG_NCH = S / RG_L;
constexpr int RG_XF = 0, RG_AF = 51200, RG_GW = 102400, RG_CWL = 142336, RG_GPL = 144256, RG_HC = 145408, RG_END = 146944;
template <int PASS>
__device__ __forceinline__ void rglru_phase(LAS unsigned char* lds, const int wid, const int G, const int bx, const bf16* proj, const float* cw, const float* cb, const bf16* gw  ,
                                            const float* gp  , float* sumA, float* sumB, bf16* cat) {
    const int lane = lane_id(), tid = wid * 64 + lane;
    LAS float* XF = (LAS float*)(lds + RG_XF); LAS float* AF = (LAS float*)(lds + RG_AF); LAS bf16* GWL = (LAS bf16*)(lds + RG_GW);
    LAS float* CWL = (LAS float*)(lds + RG_CWL); LAS float* GPL = (LAS float*)(lds + RG_GPL); LAS float* HC = (LAS float*)(lds + RG_HC);
    constexpr int NU = NB * RG_NCH * 8;
    const int tk = tid >> 2, cq = tid & 3, ch0 = cq * 24;
    u32x4 xv[4][3];
#define RG_LOADX(uu) do { const int b_ = (uu) / (RG_NCH * 8), c_ = ((uu) / 8) % RG_NCH, g_ = (uu) % 8; const int s_ = c_ * RG_L + tk; const bf16* xr_ = proj + ((size_t)b_ * S + s_) * PLD + g_ * 96 + ch0; \
        _Pragma("unroll") for (int w = 0; w < 4; ++w) _Pragma("unroll") for (int q = 0; q < 3; ++q) xv[w][q] = (s_ + w - 3 >= 0) ? *(const u32x4*)(xr_ + (ptrdiff_t)(w - 3) * PLD + 8 * q) : (u32x4){0u, 0u, 0u, 0u}; } while (0)
    int u = bx, k = 0, gc = -1;
    if (u < NU) RG_LOADX(u);
    for (; u < NU; u += G, ++k) {
        const int b = u / (RG_NCH * 8), c = (u / 8) % RG_NCH, g = u % 8;
        const size_t t = (size_t)b * S + c * RG_L + tk;
        if (g != gc) {
            __syncthreads();
            for (int idx = tid; idx < 2 * 96 * 12; idx += NTHR) { const int row = idx / 12, ch = idx % 12; *(LAS u32x4*)(GWL + row * 104 + ch * 8) = *(const u32x4*)(gw + ((size_t)((row / 96) * 8 + g) * 96 + (row % 96)) * 96 + ch * 8); }
            if (tid < 480) CWL[tid] = (tid < 384) ? cw[(tid / 96) * TW + g * 96 + (tid % 96)] : cb[g * 96 + tid - 384];
            if (tid < 288) GPL[tid] = gp[(tid / 96) * TW + g * 96 + (tid % 96)];
            gc = g;
            __syncthreads();
        }
        if (PASS == 2 && (k & 3) == 0) {
            const int p = wid >> 1, chh = tid & 127, up = u + G * p;
            if (chh < 96 && up < NU) {
                const int bp = up / (RG_NCH * 8), cp = (up / 8) % RG_NCH, gpp = up % 8;
                const float* pa = sumA + (size_t)bp * RG_NCH * TW + gpp * 96 + chh; const float* pb = sumB + (size_t)bp * RG_NCH * TW + gpp * 96 + chh;
                float hc = 0.f;
                for (int cc = 0; cc < cp; cc += 16) { float av[16], bv[16];
#pragma unroll
                    for (int q = 0; q < 16; ++q) { const bool ok = cc + q < cp; av[q] = ok ? pa[(size_t)(cc + q) * TW] : 1.f; bv[q] = ok ? pb[(size_t)(cc + q) * TW] : 0.f; }
#pragma unroll
                    for (int q = 0; q < 16; ++q) hc = av[q] * hc + bv[q]; }
                HC[p * 96 + chh] = hc;
            }
        }
        u32x4 ugv[3];
        if (PASS == 2) { const bf16* ugr = proj + t * PLD + TW + g * 96 + ch0;
#pragma unroll
            for (int q = 0; q < 3; ++q) ugv[q] = *(const u32x4*)(ugr + 8 * q); }
        {
            float acc[24];
#pragma unroll
            for (int q = 0; q < 6; ++q) { const f32x4 v = *(const LAS f32x4*)(CWL + 384 + ch0 + 4 * q); acc[4 * q] = v[0]; acc[4 * q + 1] = v[1]; acc[4 * q + 2] = v[2]; acc[4 * q + 3] = v[3]; }
#pragma unroll
            for (int w = 0; w < 4; ++w)
#pragma unroll
                for (int q = 0; q < 3; ++q) { const u32x4 x = xv[w][q];
                    const f32x4 w0 = *(const LAS f32x4*)(CWL + w * 96 + ch0 + 8 * q), w1 = *(const LAS f32x4*)(CWL + w * 96 + ch0 + 8 * q + 4);
                    acc[8 * q + 0] += w0[0] * bflo(x.x); acc[8 * q + 1] += w0[1] * bfhi(x.x); acc[8 * q + 2] += w0[2] * bflo(x.y); acc[8 * q + 3] += w0[3] * bfhi(x.y);
                    acc[8 * q + 4] += w1[0] * bflo(x.z); acc[8 * q + 5] += w1[1] * bfhi(x.z); acc[8 * q + 6] += w1[2] * bflo(x.w); acc[8 * q + 7] += w1[3] * bfhi(x.w); }
#pragma unroll
            for (int q = 0; q < 6; ++q) *(LAS f32x4*)(XF + tk * 100 + ch0 + 4 * q) = (f32x4){acc[4 * q], acc[4 * q + 1], acc[4 * q + 2], acc[4 * q + 3]};
        }
        __syncthreads();
        if (u + G < NU) RG_LOADX(u + G);
        {
            const int fr = lane & 15, fq = lane >> 4;
            bf16x8 af[3];
#pragma unroll
            for (int ks = 0; ks < 3; ++ks) { const f32x4 x0 = *(const LAS f32x4*)(XF + (16 * wid + fr) * 100 + ks * 32 + 8 * fq), x1 = *(const LAS f32x4*)(XF + (16 * wid + fr) * 100 + ks * 32 + 8 * fq + 4);
                u32x4 w; w.x = cvt_pk_bf16(x0[0], x0[1]); w.y = cvt_pk_bf16(x0[2], x0[3]); w.z = cvt_pk_bf16(x1[0], x1[1]); w.w = cvt_pk_bf16(x1[2], x1[3]); af[ks] = __builtin_bit_cast(bf16x8, w); }
#pragma unroll
            for (int nt = 0; nt < 6; ++nt) {
                f32x4 dr = (f32x4){0.f, 0.f, 0.f, 0.f}, di = dr;
#pragma unroll
                for (int ks = 0; ks < 3; ++ks) {
                    const bf16x8 br = *(const LAS bf16x8*)(GWL + (nt * 16 + fr) * 104 + ks * 32 + 8 * fq);
                    const bf16x8 bi = *(const LAS bf16x8*)(GWL + (96 + nt * 16 + fr) * 104 + ks * 32 + 8 * fq);
                    dr = __builtin_amdgcn_mfma_f32_16x16x32_bf16(af[ks], br, dr, 0, 0, 0);
                    di = __builtin_amdgcn_mfma_f32_16x16x32_bf16(af[ks], bi, di, 0, 0, 0);
                }
                const int ch = nt * 16 + fr;
                const float ba = GPL[ch], bxx = GPL[96 + ch], c8 = GPL[192 + ch];
#pragma unroll
                for (int i = 0; i < 4; ++i) {
                    const int tkk = 16 * wid + 4 * fq + i;
                    const float r = fast_sigmoid(dr[i] + ba), ig = fast_sigmoid(di[i] + bxx);
                    const float la = c8 * r;
                    const float a = __expf(la);
                    const float x2 = 2.0f * la;
                    float p = 1.0f + x2 * (1.0f / 7.0f); p = 1.0f + x2 * (1.0f / 6.0f) * p; p = 1.0f + x2 * (1.0f / 5.0f) * p; p = 1.0f + x2 * 0.25f * p; p = 1.0f + x2 * (1.0f / 3.0f) * p; p = 1.0f + x2 * 0.5f * p;
                    float om = -x2 * p;
                    if (x2 < -0.25f) om = 1.0f - a * a;
                    const float bc = __builtin_amdgcn_sqrtf(om);
                    const float xc = XF[tkk * 100 + ch];
                    AF[tkk * 100 + ch] = a;
                    XF[tkk * 100 + ch] = bc * (ig * xc);
                }
            }
        }
        __syncthreads();
        if (tid < 96) {
            float h = (PASS == 2) ? HC[(k & 3) * 96 + tid] : 0.f, ap = 1.f;
            for (int k0 = 0; k0 < RG_L; k0 += 16) {
                float av[16], bv[16];
#pragma unroll
                for (int q = 0; q < 16; ++q) { av[q] = AF[(k0 + q) * 100 + tid]; bv[q] = XF[(k0 + q) * 100 + tid]; }
#pragma unroll
                for (int q = 0; q < 16; ++q) { h = av[q] * h + bv[q]; if (PASS == 1) ap *= av[q]; else XF[(k0 + q) * 100 + tid] = h; }
            }
            if (PASS == 1) { sumA[((size_t)b * RG_NCH + c) * TW + g * 96 + tid] = ap; sumB[((size_t)b * RG_NCH + c) * TW + g * 96 + tid] = h; }
        }
        if (PASS == 2) {
            __syncthreads();
            bf16* orow = cat + t * D + g * 96 + ch0;
#pragma unroll
            for (int q = 0; q < 3; ++q) {
                const u32x4 uv = ugv[q];
                const f32x4 h0 = *(const LAS f32x4*)(XF + tk * 100 + ch0 + 8 * q), h1 = *(const LAS f32x4*)(XF + tk * 100 + ch0 + 8 * q + 4);
                u32x4 w;
                w.x = cvt_pk_bf16(h0[0] * gelu_tanh_fast(bflo(uv.x)), h0[1] * gelu_tanh_fast(bfhi(uv.x)));
                w.y = cvt_pk_bf16(h0[2] * gelu_tanh_fast(bflo(uv.y)), h0[3] * gelu_tanh_fast(bfhi(uv.y)));
                w.z = cvt_pk_bf16(h1[0] * gelu_tanh_fast(bflo(uv.z)), h1[1] * gelu_tanh_fast(bfhi(uv.z)));
                w.w = cvt_pk_bf16(h1[2] * gelu_tanh_fast(bflo(uv.w)), h1[3] * gelu_tanh_fast(bfhi(uv.w)));
                *(u32x4*)(orow + 8 * q) = w;
            }
        }
        __syncthreads();
    }
#undef RG_LOADX
}

namespace att {
typedef float f32x16 __attribute__((ext_vector_type(16)));
typedef short s16x4 __attribute__((ext_vector_type(4)));
constexpr int SLOT = 32768, NSLOT = 3, L_K = 0, L_V = 16384;
constexpr int L_WSF = NSLOT * SLOT, L_TB = L_WSF + 8 * 256, L_END = L_TB + 512;
constexpr int L_X = 0, L_OST = 65536;
constexpr float THR = 8.0f, LOG2E = 1.4426950408889634f;
static_assert(L_END <= RING_BYTES && L_OST + 32768 <= L_WSF, "attention LDS map");
__device__ __forceinline__ int crow(int r, int hi) { return (r & 3) + 8 * (r >> 2) + 4 * hi; }
#define ATT_WAIT_BAR(N) asm volatile("s_waitcnt vmcnt(" #N ") lgkmcnt(0)\n\ts_barrier" ::: "memory")
#define ATT_MFMA(a, b, c) __builtin_amdgcn_mfma_f32_32x32x16_bf16(a, b, c, 0, 0, 0)

template <int MODE>
__device__ __forceinline__ void attn_unit(LAS unsigned char* lds, const int wid, const int b, const int hh, const int qb,
                                          const bf16* proj, const bf16* kvm, const int layer, const int qoff, const float* rel_bias, const float* subg, const float lam, const float lambda_init, bf16* cat) {
    const int lane = lane_id(), r32 = lane & 31, hi = lane >> 5, mp = wid >> 2, wq = wid & 3, tid = wid * 64 + lane;
    const int q0 = qb * 128, qw0 = q0 + 32 * wq, qrow = qw0 + r32;
    const int NT = (MODE == 0) ? (q0 + 128) / 64 : 4;
    constexpr int NDB = (MODE == 0) ? 4 : 2;
    const bf16* Qp; const bf16* Kg0; const bf16* Kg1; const bf16* Vg0; const bf16* Vg1; int ldk;
    if (MODE == 0) { const bf16* pb_ = proj + (size_t)b * S * PLD; Qp = pb_ + (size_t)qrow * PLD + hh * 128 + mp * 64; Kg0 = pb_ + 768 + hh * 128; Kg1 = Kg0 + 64; Vg0 = pb_ + 1536 + hh * 128; Vg1 = Vg0; ldk = PLD; }
    else { const bf16* kb_ = kvm + (size_t)b * ML * 2048 + layer * 512; Qp = proj + ((size_t)b * S + qrow) * PLD + qoff + (hh * 2 + mp) * 64; Kg0 = kb_ + (hh * 2) * 64; Kg1 = Kg0 + 64; Vg0 = Kg0 + 256; Vg1 = Kg1 + 256; ldk = 2048; }
    const bf16* ks0 = Kg0 + (size_t)lane * ldk + wid * 8; const bf16* ks1 = Kg1 + (size_t)lane * ldk + wid * 8;
    const bf16* vs[2];
#pragma unroll
    for (int i = 0; i < 2; ++i) { const int pc = wid * 2 + i, rg = pc & 3;
        if (MODE == 0) vs[i] = Vg0 + (size_t)(16 * rg + (lane >> 2)) * ldk + (pc >> 2) * 32 + (lane & 3) * 8;
        else vs[i] = ((pc >> 3) ? Vg1 : Vg0) + (size_t)(16 * rg + (lane >> 2)) * ldk + ((pc >> 2) & 1) * 32 + (lane & 3) * 8; }
    const size_t tstep = (size_t)64 * ldk;
    const unsigned lds0 = (unsigned)(uintptr_t)lds;
#define ATT_GLDS(gsrc, dst) do { unsigned keep_; asm volatile("s_mov_b32 %0, m0\n\ts_mov_b32 m0, %2\n\ts_nop 0\n\tglobal_load_lds_dwordx4 %1, off\n\ts_mov_b32 m0, %0" : "=&s"(keep_) : "v"(gsrc), "s"((unsigned)__builtin_amdgcn_readfirstlane(dst)) : "memory"); } while (0)
#define ATT_DMA(t, slot) do { const unsigned sb_ = lds0 + (unsigned)((slot) * SLOT); \
        ATT_GLDS(ks0 + (size_t)(t) * tstep, sb_ + L_K + wid * 1024); \
        ATT_GLDS(ks1 + (size_t)(t) * tstep, sb_ + L_K + 8192 + wid * 1024); \
        ATT_GLDS(vs[0] + (size_t)(t) * tstep, sb_ + L_V + wid * 2048); \
        ATT_GLDS(vs[1] + (size_t)(t) * tstep, sb_ + L_V + wid * 2048 + 1024); } while (0)
    ATT_DMA(0, 0);
    if (NT > 1) ATT_DMA(1, 1);
    if (NT > 2) ATT_DMA(2, 2);
    LAS float* tb = (LAS float*)(lds + L_TB); LAS float* wsf = (LAS float*)(lds + L_WSF) + wid * 64;
    if (MODE == 0 && tid < 128) tb[tid] = (rel_bias[(int)BUCKET[tid] * 6 + hh] - rel_bias[31 * 6 + hh]) * LOG2E;
    bf16x8 qr[4];
#pragma unroll
    for (int d0 = 0; d0 < 4; ++d0) qr[d0] = *(const bf16x8*)(Qp + d0 * 16 + hi * 8);
    asm volatile("" : "+v"(qr[0]), "+v"(qr[1]), "+v"(qr[2]), "+v"(qr[3]));
    f32x16 o[NDB];
#pragma unroll
    for (int d0 = 0; d0 < NDB; ++d0) o[d0] = (f32x16){0.f, 0.f, 0.f, 0.f, 0.f, 0.f, 0.f, 0.f, 0.f, 0.f, 0.f, 0.f, 0.f, 0.f, 0.f, 0.f};
    float mref = -INFINITY, lsum = 0.f;
    f32x16 negm;
#pragma unroll
    for (int r = 0; r < 16; ++r) negm[r] = 0.f;
    const int koff = hi * 1024 + r32 * 16 + mp * 8192;
    const int voff = L_V + ((MODE == 1) ? mp * 8192 : 0) + ((lane >> 4) & 1) * 32 + (lane & 3) * 8 + (4 * hi + ((lane & 15) >> 2)) * 64;
    ATT_WAIT_BAR(0);
    bf16x8 kf[8];
    {
        const LAS unsigned char* kp = lds + L_K + koff;
#pragma unroll
        for (int d0 = 0; d0 < 4; ++d0) { kf[2 * d0] = *(const LAS bf16x8*)(kp + d0 * 2048); kf[2 * d0 + 1] = *(const LAS bf16x8*)(kp + d0 * 2048 + 512); }
    }
    int slot = 0;
    for (int t = 0; t < NT; ++t) {
        const int slot_n = (slot + 1 >= NSLOT) ? 0 : slot + 1;
        const LAS unsigned char* sb = lds + slot * SLOT;
        f32x16 p0, p1;
        p0 = ATT_MFMA(kf[0], qr[0], negm); p1 = ATT_MFMA(kf[1], qr[0], negm);
        p0 = ATT_MFMA(kf[2], qr[1], p0); p1 = ATT_MFMA(kf[3], qr[1], p1);
        p0 = ATT_MFMA(kf[4], qr[2], p0); p1 = ATT_MFMA(kf[5], qr[2], p1);
        p0 = ATT_MFMA(kf[6], qr[3], p0); p1 = ATT_MFMA(kf[7], qr[3], p1);
        __builtin_amdgcn_sched_barrier(0);
        if (MODE == 0) {
            if (64 * t + 63 + 112 >= qw0) {
                const int nb = qrow - 64 * t - 4 * hi;
#pragma unroll
                for (int r = 0; r < 16; ++r) { const int n0 = nb - ((r & 3) + 8 * (r >> 2)), n1 = n0 - 32;
                    const float b0 = tb[n0 < 0 ? 0 : (n0 > 127 ? 127 : n0)], b1 = tb[n1 < 0 ? 0 : (n1 > 127 ? 127 : n1)];
                    p0[r] = n0 < 0 ? -INFINITY : p0[r] + b0; p1[r] = n1 < 0 ? -INFINITY : p1[r] + b1; }
            }
        }
        float rm = fmaxf(p0[0], p1[0]);
#pragma unroll
        for (int r = 1; r < 16; ++r) rm = fmaxf(rm, fmaxf(p0[r], p1[r]));
        { auto rr = __builtin_amdgcn_permlane32_swap(__float_as_uint(rm), __float_as_uint(rm), false, false); rm = fmaxf(__uint_as_float(rr[0]), __uint_as_float(rr[1])); }
        const bool grow = (mref == -INFINITY) ? true : (rm > THR);
        if (__any(grow)) {
            const float dl = (mref == -INFINITY) ? rm : fmaxf(rm, 0.f);
            const float alpha = (mref == -INFINITY) ? 0.f : __builtin_amdgcn_exp2f(-dl);
            mref = (mref == -INFINITY) ? rm : mref + dl;
#pragma unroll
            for (int r = 0; r < 16; ++r) { p0[r] -= dl; p1[r] -= dl; negm[r] = -mref; }
            lsum *= alpha;
            if (hi == 0) wsf[r32] = alpha;
            asm volatile("s_waitcnt lgkmcnt(0)" ::: "memory");
#pragma unroll
            for (int r = 0; r < 16; ++r) { const float a = wsf[crow(r, hi)];
#pragma unroll
                for (int d0 = 0; d0 < NDB; ++d0) o[d0][r] *= a; }
        }
        float sacc = 0.f;
#pragma unroll
        for (int r = 0; r < 16; ++r) { p0[r] = __builtin_amdgcn_exp2f(p0[r]); p1[r] = __builtin_amdgcn_exp2f(p1[r]); sacc += p0[r] + p1[r]; }
        lsum += sacc;
        u32x4 pw[4];
#pragma unroll
        for (int k = 0; k < 4; ++k) { pw[0][k] = cvt_pk_bf16(p0[2 * k], p0[2 * k + 1]); pw[1][k] = cvt_pk_bf16(p0[8 + 2 * k], p0[9 + 2 * k]); pw[2][k] = cvt_pk_bf16(p1[2 * k], p1[2 * k + 1]); pw[3][k] = cvt_pk_bf16(p1[8 + 2 * k], p1[9 + 2 * k]); }
        __builtin_amdgcn_sched_barrier(0);
        {
            const LAS unsigned char* vp = sb + voff;
            const LAS unsigned char* kpn = lds + slot_n * SLOT + L_K + koff;
#define ATT_VLD(idx, lo_, hv_) do { lo_ = __builtin_bit_cast(s16x4, __builtin_amdgcn_ds_read_tr16_b64_v4i16((LAS s16x4*)(vp + ((idx) >> 2) * 4096 + ((idx) & 3) * 1024))); \
                                    hv_ = __builtin_bit_cast(s16x4, __builtin_amdgcn_ds_read_tr16_b64_v4i16((LAS s16x4*)(vp + ((idx) >> 2) * 4096 + ((idx) & 3) * 1024 + 512))); } while (0)
            s16x4 lo[2], hv[2];
            ATT_VLD(0, lo[0], hv[0]);
#pragma unroll
            for (int idx = 0; idx < 4 * NDB; ++idx) {
                const int cur = idx & 1, nx = cur ^ 1;
                if (idx + 1 < 4 * NDB) ATT_VLD(idx + 1, lo[nx], hv[nx]);
                if (idx < 8) kf[idx] = *(const LAS bf16x8*)(kpn + (idx >> 1) * 2048 + (idx & 1) * 512);
                __builtin_amdgcn_sched_barrier(0);
                const bf16x8 vf = (bf16x8){lo[cur][0], lo[cur][1], lo[cur][2], lo[cur][3], hv[cur][0], hv[cur][1], hv[cur][2], hv[cur][3]};
                o[idx >> 2] = ATT_MFMA(__builtin_bit_cast(bf16x8, pw[idx & 3]), vf, o[idx >> 2]);
                __builtin_amdgcn_sched_barrier(0);
            }
#undef ATT_VLD
        }
        ATT_WAIT_BAR(0);
        if (t + 3 < NT) ATT_DMA(t + 3, slot);
        slot = slot_n;
    }
    { auto rr = __builtin_amdgcn_permlane32_swap(__float_as_uint(lsum), __float_as_uint(lsum), false, false); lsum = __uint_as_float(rr[0]) + __uint_as_float(rr[1]); }
    if (hi == 0) wsf[32 + r32] = 1.0f / lsum;
    asm volatile("s_waitcnt lgkmcnt(0)" ::: "memory");
#pragma unroll
    for (int r = 0; r < 16; ++r) { const float a = wsf[32 + crow(r, hi)];
#pragma unroll
        for (int d0 = 0; d0 < NDB; ++d0) o[d0][r] *= a; }
    if (MODE == 0) {
        LAS float* X = (LAS float*)(lds + L_X);
        if (mp == 1) {
#pragma unroll
            for (int d0 = 0; d0 < 4; ++d0)
#pragma unroll
                for (int r = 0; r < 16; ++r) X[((wq * 4 + d0) * 16 + r) * 64 + lane] = o[d0][r];
        }
        ATT_WAIT_BAR(0);
        if (mp == 0) {
            float ss[16];
#pragma unroll
            for (int r = 0; r < 16; ++r) { float a = 0.f;
#pragma unroll
                for (int d0 = 0; d0 < 4; ++d0) { const float v = o[d0][r] - lam * X[((wq * 4 + d0) * 16 + r) * 64 + lane]; o[d0][r] = v; a += v * v; }
                ss[r] = a; }
#pragma unroll
            for (int off = 1; off < 32; off <<= 1)
#pragma unroll
                for (int r = 0; r < 16; ++r) ss[r] += __shfl_xor(ss[r], off);
            float gd[4];
#pragma unroll
            for (int d0 = 0; d0 < 4; ++d0) gd[d0] = subg[d0 * 32 + r32] * (1.0f - lambda_init);
            LAS bf16* ost = (LAS bf16*)(lds + L_OST) + wq * 4096;
#pragma unroll
            for (int r = 0; r < 16; ++r) { const float rn = rsqrtf(ss[r] * (1.0f / 128.0f) + EPS); const int row = crow(r, hi);
#pragma unroll
                for (int d0 = 0; d0 < 4; ++d0) ost[row * 128 + d0 * 32 + r32] = (bf16)(cvt_pk_bf16(o[d0][r] * rn * gd[d0], 0.f) & 0xffffu); }
            asm volatile("s_waitcnt lgkmcnt(0)" ::: "memory");
            bf16* op = cat + ((size_t)b * S + qw0) * D + hh * 128;
#pragma unroll
            for (int i = 0; i < 8; ++i) { const int c = i * 64 + lane, row = c >> 4, ch = c & 15; *(u32x4*)(op + (size_t)row * D + ch * 8) = *(const LAS u32x4*)(ost + row * 128 + ch * 8); }
        }
    } else {
        LAS bf16* ost = (LAS bf16*)(lds + L_OST) + wid * 2048;
#pragma unroll
        for (int r = 0; r < 16; ++r) { const int row = crow(r, hi);
#pragma unroll
            for (int d0 = 0; d0 < 2; ++d0) ost[row * 64 + d0 * 32 + r32] = (bf16)(cvt_pk_bf16(o[d0][r], 0.f) & 0xffffu); }
        asm volatile("s_waitcnt lgkmcnt(0)" ::: "memory");
        bf16* op = cat + ((size_t)b * S + qw0) * D + TW + (hh * 2 + mp) * 64;
#pragma unroll
        for (int i = 0; i < 4; ++i) { const int c = i * 64 + lane, row = c >> 3, ch = c & 7; *(u32x4*)(op + (size_t)row * D + ch * 8) = *(const LAS u32x4*)(ost + row * 64 + ch * 8); }
    }
    ATT_WAIT_BAR(0);
#undef ATT_DMA
#undef ATT_GLDS
}
__device__ __forceinline__ void attn_phase(LAS unsigned char* lds, const int wave, const bool diff, unsigned* qctr, volatile LAS unsigned* qword,
                                           const bf16* proj, const bf16* kvm, const int layer, const int qoff, const float* rel_bias, const float* lq1, const float* lk1, const float* lq2, const float* lk2,
                                           const float* subg, const float lambda_init, bf16* cat) {
    float lam = 0.f;
    if (diff) { const int l = lane_id(); lam = __expf(wave_sum(lq1[l] * lk1[l])) - __expf(wave_sum(lq2[l] * lk2[l])) + lambda_init; }
    const int ndiff = diff ? NB * 6 * (S / 128) : 0, ntot = ndiff + NB * 2 * (S / 128);
    for (;;) {
        if (wave == 0 && lane_id() == 0) qword[0] = __hip_atomic_fetch_add(qctr, 1u, __ATOMIC_RELAXED, __HIP_MEMORY_SCOPE_AGENT);
        __syncthreads();
        const int u = __builtin_amdgcn_readfirstlane((int)qword[0]);
        if (u >= ntot) break;
        if (u < ndiff) { const int bh = u % 12; attn_unit<0>(lds, wave, bh / 6, bh % 6, 63 - u / 12, proj, kvm, layer, qoff, rel_bias, subg, lam, lambda_init, cat); }
        else { const int v = u - ndiff; attn_unit<1>(lds, wave, v >> 7, (v >> 6) & 1, v & 63, proj, kvm, layer, qoff, rel_bias, subg, lam, lambda_init, cat); }
    }
    __syncthreads();
}
#undef ATT_WAIT_BAR
#undef ATT_MFMA
}

constexpr int GT_TABA = LDSCTL_OFF + 4096, GT_TABS = LDSCTL_OFF + 6144;
constexpr int RT_TAB = LDSCTL_OFF + 1024;
typedef float f32x2 __attribute__((ext_vector_type(2)));
__device__ __forceinline__ void route_phase(LAS unsigned char* lds, const int wave, const float* h, const float* g, const float* wg, const float* wr, bf16* hn, unsigned* gcnt, int* list, float* ew, int G, int bx) {
    const int lane = lane_id(), tid = wave * 64 + lane;
    LAS float* WL = (LAS float*)lds;
    LAS int* lcnt = (LAS int*)(lds + RT_TAB); LAS int* lbase = lcnt + 16; LAS int* rinfo = lcnt + 32; LAS float* rw = (LAS float*)(lcnt + 32 + 256);
    for (int idx = tid; idx < 20 * D; idx += NTHR) { const int o = idx >> 10, d = idx & 1023; WL[idx] = (o < 4) ? wg[d * 4 + o] : wr[d * 16 + (o - 4)]; }
    f32x4 gg[4];
#pragma unroll
    for (int j = 0; j < 4; ++j) gg[j] = ((const f32x4*)g)[64 * j + lane];
    __syncthreads();
    const int b16 = (lane >> 4) & 1, b8 = (lane >> 3) & 1, hb = lane & 32;
    for (int ck = bx; ck < T / 64; ck += G) {
        if (tid < 16) lcnt[tid] = 0;
        __syncthreads();
        f32x4 n0[4], n1[4];
        { const float* p = h + ((size_t)ck * 64 + wave * 8) * D;
#pragma unroll
            for (int j = 0; j < 4; ++j) { n0[j] = ((const f32x4*)p)[64 * j + lane]; n1[j] = ((const f32x4*)(p + D))[64 * j + lane]; } }
        for (int it = 0; it < 4; ++it) {
            const int r0 = wave * 8 + it * 2; const size_t m0 = (size_t)ck * 64 + r0;
            f32x4 v0[4], v1[4]; float ss0 = 0.f, ss1 = 0.f;
#pragma unroll
            for (int j = 0; j < 4; ++j) { v0[j] = n0[j]; v1[j] = n1[j];
                ss0 += (v0[j][0] * v0[j][0] + v0[j][1] * v0[j][1]) + (v0[j][2] * v0[j][2] + v0[j][3] * v0[j][3]);
                ss1 += (v1[j][0] * v1[j][0] + v1[j][1] * v1[j][1]) + (v1[j][2] * v1[j][2] + v1[j][3] * v1[j][3]); }
            if (it < 3) { const float* p = h + (m0 + 2) * D;
#pragma unroll
                for (int j = 0; j < 4; ++j) { n0[j] = ((const f32x4*)p)[64 * j + lane]; n1[j] = ((const f32x4*)(p + D))[64 * j + lane]; } }
            const float rs0 = rsqrtf(wave_sum(ss0) * (1.0f / D) + EPS), rs1 = rsqrtf(wave_sum(ss1) * (1.0f / D) + EPS);
            f32x2 x2[4][4];
#pragma unroll
            for (int j = 0; j < 4; ++j) { v0[j] = v0[j] * rs0 * gg[j]; v1[j] = v1[j] * rs1 * gg[j];
                u32x2 w; w.x = cvt_pk_bf16(v0[j][0], v0[j][1]); w.y = cvt_pk_bf16(v0[j][2], v0[j][3]); ((u32x2*)(hn + m0 * D))[64 * j + lane] = w;
                w.x = cvt_pk_bf16(v1[j][0], v1[j][1]); w.y = cvt_pk_bf16(v1[j][2], v1[j][3]); ((u32x2*)(hn + (m0 + 1) * D))[64 * j + lane] = w;
#pragma unroll
                for (int c = 0; c < 4; ++c) x2[j][c] = (f32x2){v0[j][c], v1[j][c]}; }
            f32x2 acc[20];
#pragma unroll
            for (int o = 0; o < 20; ++o) { f32x2 a = (f32x2){0.f, 0.f};
#pragma unroll
                for (int j = 0; j < 4; ++j) { const f32x4 w4 = *(const LAS f32x4*)(WL + o * D + 256 * j + 4 * lane);
#pragma unroll
                    for (int c = 0; c < 4; ++c) a = __builtin_elementwise_fma(x2[j][c], (f32x2){w4[c], w4[c]}, a); }
                acc[o] = a; }
            float k1[20];
#pragma unroll
            for (int o = 0; o < 20; ++o) { auto rr = __builtin_amdgcn_permlane32_swap(__float_as_uint(acc[o].x), __float_as_uint(acc[o].y), false, false); k1[o] = __uint_as_float(rr[0]) + __uint_as_float(rr[1]); }
            float k2[10];
#pragma unroll
            for (int o = 0; o < 10; ++o) { const float snd = b16 ? k1[o] : k1[10 + o], kp = b16 ? k1[10 + o] : k1[o]; k2[o] = kp + __shfl_xor(snd, 16); }
            float k3[5];
#pragma unroll
            for (int o = 0; o < 5; ++o) { const float snd = b8 ? k2[o] : k2[5 + o], kp = b8 ? k2[5 + o] : k2[o]; k3[o] = kp + __shfl_xor(snd, 8); }
#pragma unroll
            for (int o = 0; o < 5; ++o) { k3[o] += __shfl_xor(k3[o], 4); k3[o] += __shfl_xor(k3[o], 2); k3[o] += __shfl_xor(k3[o], 1); }
            float lg[20];
#pragma unroll
            for (int gq = 0; gq < 4; ++gq)
#pragma unroll
                for (int q = 0; q < 5; ++q) lg[gq * 5 + q] = __shfl(k3[q], hb | (gq << 3));
            {
                int gi = 0; float gm = lg[0];
#pragma unroll
                for (int o = 1; o < 4; ++o) if (lg[o] > gm) { gm = lg[o]; gi = o; }
                float gs = 0.f;
#pragma unroll
                for (int o = 0; o < 4; ++o) gs += __expf(lg[o] - gm);
                const float gwt = 1.0f / gs;
                float e[4];
#pragma unroll
                for (int k = 0; k < 4; ++k) { e[k] = lg[4 + k];
#pragma unroll
                    for (int q = 1; q < 4; ++q) if (gi == q) e[k] = lg[4 + q * 4 + k]; }
                int i1 = 0; float x1 = e[0];
#pragma unroll
                for (int k = 1; k < 4; ++k) if (e[k] > x1) { x1 = e[k]; i1 = k; }
                int i2 = 0; float x2v = -INFINITY;
#pragma unroll
                for (int k = 0; k < 4; ++k) if (k != i1 && e[k] > x2v) { x2v = e[k]; i2 = k; }
                const float ex = __expf(x2v - x1); const float w1 = gwt / (1.0f + ex), w2 = w1 * ex;
                if ((lane & 31) == 0) { const int e0 = gi * 4 + i1, e1 = gi * 4 + i2, rl = r0 + (lane >> 5);
                    const int q0 = __hip_atomic_fetch_add(lcnt + e0, 1, __ATOMIC_RELAXED, __HIP_MEMORY_SCOPE_WORKGROUP);
                    const int q1 = __hip_atomic_fetch_add(lcnt + e1, 1, __ATOMIC_RELAXED, __HIP_MEMORY_SCOPE_WORKGROUP);
                    rinfo[rl * 4] = e0; rinfo[rl * 4 + 1] = q0; rinfo[rl * 4 + 2] = e1; rinfo[rl * 4 + 3] = q1; rw[rl * 2] = w1; rw[rl * 2 + 1] = w2; }
            }
        }
        __syncthreads();
        if (tid < 16) { const int cn = lcnt[tid]; lbase[tid] = cn ? (int)__hip_atomic_fetch_add(gcnt + tid, (unsigned)cn, __ATOMIC_RELAXED, __HIP_MEMORY_SCOPE_AGENT) : 0; }
        __syncthreads();
        if (tid < 64) { const int t = ck * 64 + tid; const int e0 = rinfo[tid * 4], q0 = rinfo[tid * 4 + 1], e1 = rinfo[tid * 4 + 2], q1 = rinfo[tid * 4 + 3];
            list[(size_t)e0 * T + lbase[e0] + q0] = 2 * t; list[(size_t)e1 * T + lbase[e1] + q1] = 2 * t + 1; ew[2 * t] = rw[tid * 2]; ew[2 * t + 1] = rw[tid * 2 + 1]; }
        __syncthreads();
    }
}
__device__ __forceinline__ void moe_table(LAS unsigned char* lds, unsigned* gcnt, bool leader) {
    LAS int* tab = (LAS int*)(lds + RT_TAB);
    if (leader) { int pre = 0;
        for (int e = 0; e < 16; ++e) { const int cn = (int)__hip_atomic_load(gcnt + e, __ATOMIC_RELAXED, __HIP_MEMORY_SCOPE_AGENT); tab[e] = cn; tab[16 + e] = pre; pre += (cn + 255) >> 8; }
        tab[32] = pre; }
    __syncthreads();
}

__global__ void __launch_bounds__(NTHR, 2) mega(Args args) {
    extern __shared__ __attribute__((aligned(16))) unsigned char lds_raw[];
    LAS unsigned char* lds = (LAS unsigned char*)lds_raw;
    const int wave = __builtin_amdgcn_readfirstlane(threadIdx.x >> 6);
#define TID() (wave * 64 + lane_id())
#define LEADER() (wave == 0 && lane_id() == 0)
    const int G = gridDim.x, bx = blockIdx.x;
    unsigned char* ws = args.ws;
    unsigned* ctl = (unsigned*)(ws + WS_CTL);
    for (int u = TID(); u < (LDS_BYTES - LDSCTL_OFF) / 4; u += NTHR) ((LAS unsigned*)(lds + LDSCTL_OFF))[u] = 0u;
    __syncthreads();
    volatile LAS unsigned* MISC = (volatile LAS unsigned*)(lds + MISC_OFF);
    const unsigned phm = (unsigned)args.ph_mask, sem = (unsigned)args.seam_mask;
    XcdBarrier bar; bar.bar = ctl + CW_BAR + args.li * XCD_BAR_WORDS; bar.x = 0; bar.st = nullptr;
    if (sem) bar = xcd_barrier_post(ctl + CW_BAR + args.li * XCD_BAR_WORDS, MISC + 8, LEADER());
#ifndef PHASE_MASK
#define PHASE_MASK 0xffff
#endif
#ifndef REP_MASK
#define REP_MASK 0x0
#endif
#define NREP(k) (1 + ((REP_MASK >> (k)) & 1))
#define IN(k) (((PHASE_MASK >> (k)) & 1) && ((phm >> (k)) & 1u))
#ifndef REP_BAR
#define REP_BAR 0
#endif
#define SEAM(k) do { if ((sem >> (k)) & 1u) { xcd_barrier(bar, LEADER()); if (REP_BAR) xcd_barrier(bar, LEADER()); } } while (0)
    const int gw = bx * NWAVES + wave, NGW = G * NWAVES;
    float* h = args.out;
    bf16* hn = (bf16*)(ws + WS_HN); bf16* cat = (bf16*)(ws + WS_CAT); bf16* proj = (bf16*)(ws + WS_PROJ);
    bf16* memn = (bf16*)(ws + WS_MEMN); bf16* kvm = (bf16*)(ws + WS_KVM); bf16* wkv = (bf16*)(ws + WS_WKV);
    bf16* gwt = (bf16*)(ws + WS_GW); float* gpar = (float*)(ws + WS_GP);
    bf16* hid = (bf16*)(ws + WS_HID); bf16* y2 = (bf16*)(ws + WS_Y2); int* list = (int*)(ws + WS_LIST); float* ew = (float*)(ws + WS_EW);
    float* sumA = (float*)(ws + WS_SUM); float* sumB = sumA + (size_t)NB * RG_NCH * TW;

    if (IN(K_PRO)) for (int rep = 0; rep < NREP(K_PRO); ++rep) {
        LAS float* scr = (LAS float*)(lds + wave * 16384);
        for (int i = 0; i < 4; ++i) {
            const int j = i >> 1, nin = (i & 1) ? INB : INA, n_win = 16 * (nin / 32);
            const int n_items = n_win + 512 + 256 + 3 * 2048;
            unsigned char* wl = ws + WS_W + (size_t)i * W_LAYER;
            const float* win = (i & 1) ? args.in[I_WINB] + (size_t)j * D * INB : args.in[I_WINA] + (size_t)j * D * INA;
            for (int it = gw; it < n_items; it += NGW) {
                int r = it;
                if (r < n_win) { const int nblk = nin / 32, kb = r / nblk, nb = r % nblk, n0 = 32 * nb;
                    const bool isq = (i & 1) ? (n0 < 768 || n0 >= 2304) : (n0 >= 1536);
                    transpose_item(win, nin, 64 * kb, n0, (bf16*)(wl + W_IN), D, n0, isq ? 0.125f * att::LOG2E : 1.0f, scr, lane_id()); continue; } r -= n_win;
                if (r < 512) { const int kb = r / 32, nb = r % 32; transpose_item(args.in[I_WOUT] + (size_t)i * D * D, D, 64 * kb, 32 * nb, (bf16*)(wl + W_OUT), D, 32 * nb, 1.0f, scr, lane_id()); continue; } r -= 512;
                if (r < 256) { const int kb = r / 16, nb = r % 16; transpose_item(args.in[I_WKV] + (size_t)i * D * 512, 512, 64 * kb, 32 * nb, wkv, D, i * 512 + 32 * nb, 1.0f, scr, lane_id()); continue; } r -= 256;
                if (r < 4096) {
                    const int which = r / 2048, rr = r % 2048, e = rr / 128, q = rr % 128, kb = q / 8, nb = q % 8, n0 = 32 * nb;
                    const float* src = (which ? args.in[I_W3] : args.in[I_W1]) + ((size_t)i * NE + e) * D * DE;
                    transpose_item(src, DE, 64 * kb, n0, (bf16*)(wl + W_13) + (size_t)e * 512 * D, D, 256 * (n0 / 128) + 128 * which + (n0 % 128), 1.0f, scr, lane_id()); continue; } r -= 4096;
                { const int e = r / 128, q = r % 128, kb = q / 32, nb = q % 32;
                    transpose_item(args.in[I_W2] + ((size_t)i * NE + e) * DE * D, D, 64 * kb, 32 * nb, (bf16*)(wl + W_2) + (size_t)e * D * DE, DE, 32 * nb, 1.0f, scr, lane_id()); }
            }
        }
        for (int idx = bx * NTHR + TID(); idx < 2 * 2 * 8 * 96 * 96; idx += G * NTHR) {
            const int k = idx % 96, n = (idx / 96) % 96, g = (idx / 9216) % 8, gate = (idx / 73728) % 2, j = idx / 147456;
            const float* src = (gate ? args.in[I_GXW] : args.in[I_GAW]) + (size_t)j * 8 * 9216;
            gwt[idx] = (bf16)(cvt_pk_bf16(src[(g * 96 + k) * 96 + n], 0.f) & 0xffffu);
        }
        for (int idx = bx * NTHR + TID(); idx < 2 * TW; idx += G * NTHR) {
            const int j = idx / TW, c = idx % TW;
            gpar[(j * 3 + 0) * TW + c] = args.in[I_GAB][idx]; gpar[(j * 3 + 1) * TW + c] = args.in[I_GXB][idx];
            const float nl = -args.in[I_LAM][idx];
            gpar[(j * 3 + 2) * TW + c] = -8.0f * (fmaxf(nl, 0.f) + log1pf(expf(-fabsf(nl))));
        }
        for (int m = gw; m < NB * ML; m += NGW) norm_row(args.in[I_MEM] + (size_t)m * D, nullptr, nullptr, nullptr, args.in[I_MNG], memn + (size_t)m * D, nullptr, lane_id());
    }
    SEAM(K_PRO);
    if (IN(K_KVM)) {
        pg8::DenseSched Sd; Sd.init(memn, wkv, NB * ML, 4 * 512, D, G, bx);
        pg8::EpiStoreBf16 E{kvm, 4 * 512};
        pg8::gemm_phase<pg8::EpiStoreBf16, pg8::DenseSched, true>(lds, wave, D, Sd, E);
    }
    SEAM(K_KVM);

    for (int i = args.l_lo; i < args.l_hi; ++i) {
        const int j = i >> 1;
        unsigned char* wl = ws + WS_W + (size_t)i * W_LAYER;
        if (IN(K_N1)) {
            if (i == 0) { for (int m = gw; m < T; m += NGW) norm_row(args.in[I_X] + (size_t)m * D, nullptr, nullptr, nullptr, args.in[I_NMG] + i * D, hn + (size_t)m * D, nullptr, lane_id()); }
            else { for (int rep = 0; rep < NREP(K_N1); ++rep) for (int m = gw; m < T; m += NGW) norm_row(h + (size_t)m * D, y2 + (size_t)(2 * m) * D, y2 + (size_t)(2 * m + 1) * D, (rep + 1 < NREP(K_N1)) ? nullptr : h + (size_t)m * D, args.in[I_NMG] + i * D, hn + (size_t)m * D, nullptr, lane_id()); }
        }
        SEAM(K_N1);
        if (IN(K_G1)) for (int rep = 0; rep < NREP(K_G1); ++rep) {
            pg8::DenseSched Sd; Sd.init(hn, (const bf16*)(wl + W_IN), T, (i & 1) ? INB : INA, D, G, bx);
            pg8::EpiStoreBf16 E{proj, PLD};
            pg8::gemm_phase<pg8::EpiStoreBf16, pg8::DenseSched, true>(lds, wave, D, Sd, E);
        }
        SEAM(K_G1);
        if (IN(K_M1) && (i & 1)) for (int rep = 0; rep < NREP(K_M1); ++rep) {
            const float lambda_init = 0.8f - 0.6f * __expf(-0.3f * (float)i);
            att::attn_phase(lds, wave, true, ctl + CW_AQ + 64 * i + 32 * rep, MISC + 16, proj, kvm, i, 2304, args.in[I_RELB], args.in[I_LQ1] + j * 64, args.in[I_LK1] + j * 64, args.in[I_LQ2] + j * 64, args.in[I_LK2] + j * 64,
                            args.in[I_SUBG] + j * 128, lambda_init, cat);
        }
        if ((i & 1) == 0) {
            if (IN(K_M1)) for (int rep = 0; rep < NREP(K_M1); ++rep)
                rglru_phase<1>(lds, wave, G, bx, proj, args.in[I_CW] + (size_t)j * 4 * TW, args.in[I_CB] + j * TW, gwt + (size_t)j * 2 * 8 * 9216, gpar + (size_t)j * 3 * TW, sumA, sumB, cat);
            if (IN(K_M1)) for (int rep = 0; rep < NREP(K_M1); ++rep) att::attn_phase(lds, wave, false, ctl + CW_AQ + 64 * i + 32 * rep, MISC + 16, proj, kvm, i, 1536, nullptr, nullptr, nullptr, nullptr, nullptr, nullptr, 0.f, cat);
            SEAM(K_M1);
            if (IN(K_M2)) for (int rep = 0; rep < NREP(K_M2); ++rep)
                rglru_phase<2>(lds, wave, G, bx, proj, args.in[I_CW] + (size_t)j * 4 * TW, args.in[I_CB] + j * TW, gwt + (size_t)j * 2 * 8 * 9216, gpar + (size_t)j * 3 * TW, sumA, sumB, cat);
            SEAM(K_M2);
        } else { SEAM(K_M1); }
        if (IN(K_G2)) for (int rep = 0; rep < NREP(K_G2); ++rep) {
            pg8::DenseSched Sd; Sd.init(cat, (const bf16*)(wl + W_OUT), T, D, D, G, bx);
            pg8::EpiResF32 E{(i == 0) ? args.in[I_X] : h, (rep + 1 < NREP(K_G2)) ? (float*)proj : h, D};
            pg8::gemm_phase<pg8::EpiResF32, pg8::DenseSched, true>(lds, wave, D, Sd, E);
        }
        SEAM(K_G2);
        if (IN(K_N2)) for (int rep = 0; rep < NREP(K_N2); ++rep) { const bool dm = rep + 1 < NREP(K_N2);
            route_phase(lds, wave, h, args.in[I_NFG] + i * D, args.in[I_WG] + (size_t)i * D * 4, args.in[I_WR] + (size_t)i * D * 16, hn, ctl + CW_CNT + 64 * i + (dm ? 32 : 0), dm ? list + 16 * T : list, dm ? ew + 4 * T : ew, G, bx); }
        SEAM(K_N2);
        if (IN(K_E1)) for (int rep = 0; rep < NREP(K_E1); ++rep) {
            moe_table(lds, ctl + CW_CNT + 64 * i, LEADER());
            pg8::MoeSched Sm{hn, (const bf16*)(wl + W_13), D, (size_t)512 * D * 2, 2, 1, list, (const LAS int*)(lds + RT_TAB), (LAS int*)(lds + GT_TABS), G, bx};
            pg8::EpiMoe1 E{hid, (const LAS int*)(lds + GT_TABS), ew};
            pg8::gemm_phase<pg8::EpiMoe1, pg8::MoeSched, true>(lds, wave, D, Sm, E);
        }
        SEAM(K_E1);
        if (IN(K_E2)) for (int rep = 0; rep < NREP(K_E2); ++rep) {
            moe_table(lds, ctl + CW_CNT + 64 * i, LEADER());
            pg8::MoeSched Sm{hid, (const bf16*)(wl + W_2), DE, (size_t)D * DE * 2, 4, 0, list, (const LAS int*)(lds + RT_TAB), (LAS int*)(lds + GT_TABS), G, bx};
            pg8::EpiMoe2 E{y2, (const LAS int*)(lds + GT_TABS)};
            pg8::gemm_phase<pg8::EpiMoe2, pg8::MoeSched, true>(lds, wave, DE, Sm, E);
        }
        SEAM(K_E2);
    }
    if (IN(K_FIN)) {
        for (int m = gw; m < T; m += NGW) norm_row(h + (size_t)m * D, y2 + (size_t)(2 * m) * D, y2 + (size_t)(2 * m + 1) * D, nullptr, args.in[I_FNG], nullptr, h + (size_t)m * D, lane_id());
    }
#undef IN
#undef SEAM
#undef TID
#undef LEADER
}

extern "C" void kernel_launch(void* const* d_in, const int* in_sizes, int n_in, void* d_out, int out_size, void* d_ws, size_t ws_size, hipStream_t stream) {
    static int grid = 0;
    if (grid == 0) {
        if (n_in != 28 || out_size != T * D || ws_size < WS_END) { fprintf(stderr, "kernel_launch: unexpected n_in %d / out_size %d / ws_size %zu\n", n_in, out_size, ws_size); grid = -1; return; }
        int dev = 0, cus = 0, per_cu = 0;
        if (hipGetDevice(&dev) != hipSuccess || hipDeviceGetAttribute(&cus, hipDeviceAttributeMultiprocessorCount, dev) != hipSuccess) { grid = -1; return; }
        if (hipFuncSetAttribute((const void*)mega, hipFuncAttributeMaxDynamicSharedMemorySize, LDS_BYTES) != hipSuccess) { fprintf(stderr, "kernel_launch: hipFuncSetAttribute failed\n"); grid = -1; return; }
        if (hipOccupancyMaxActiveBlocksPerMultiprocessor(&per_cu, (const void*)mega, NTHR, LDS_BYTES) != hipSuccess || per_cu < 1) fprintf(stderr, "kernel_launch: occupancy query says %d\n", per_cu);
        (void)hipGetLastError();
        grid = cus;
    }
    if (grid < 0) return;
    (void)hipMemsetAsync((char*)d_ws + WS_CTL, 0, CTL_ZERO_BYTES, stream);
    Args a{};
    for (int i = 0; i < 28; ++i) a.in[i] = (const float*)d_in[i];
    a.out = (float*)d_out; a.ws = (unsigned char*)d_ws;
    a.l_lo = 0; a.l_hi = 4; a.ph_mask = (1 << K_NUM) - 1; a.seam_mask = ((1 << K_NUM) - 1) & ~(1 << K_FIN) & ~(1 << K_KVM); a.li = 0;
    hipLaunchKernelGGL(mega, dim3(grid), dim3(NTHR), LDS_BYTES, stream, a);
}
```
